# Optimizing an MI355X kernel written in HIP

```python
import math
import jax, jax.numpy as jnp
from jax import lax
import numpy as np

D_MODEL = 1024
BATCH = 32
SEQ = 2048
DEPTH = 2

D_MIX = D_MODEL
D_A = D_MIX // 2
D_B = D_MIX - D_A
N_HEADS_A = 8
HEAD_DIM_A = D_A // N_HEADS_A
N_GROUPS_B = 8
CHUNK = 128
CONV_WIDTH = 3
D_FF = 2816
N_MOD = 9
D_IN_PROJ = 2 * D_A + 3 * D_B
EPS = 1e-6

kernel_name = "hybrid_sgu_shortconv_macaron_adaln"


def rms_norm(x, g):
    xf = x.astype(jnp.float32)
    y = xf * lax.rsqrt(jnp.mean(xf * xf, axis=-1, keepdims=True) + EPS)
    return (y * g.astype(jnp.float32)).astype(x.dtype)


def layer_norm(x, g, b):
    xf = x.astype(jnp.float32)
    mu = jnp.mean(xf, axis=-1, keepdims=True)
    var = jnp.mean(jnp.square(xf - mu), axis=-1, keepdims=True)
    y = (xf - mu) * lax.rsqrt(var + EPS)
    return (y * g.astype(jnp.float32) + b.astype(jnp.float32)).astype(x.dtype)


def modulate(h, shift, scale):
    return h * (1 + scale[:, None, :]) + shift[:, None, :]


def swiglu_ffn(h, w_gu, w_down):
    gu = jnp.einsum('bsd,df->bsf', h, w_gu)
    g, u = jnp.split(gu, 2, axis=-1)
    return jnp.einsum('bsf,fd->bsd', jax.nn.silu(g) * u, w_down)


def chunked_sgu(u, v, ln_g, ln_b, w_s, b_s):
    bsz, s, _ = v.shape
    n_chunks = s // CHUNK
    v = layer_norm(v.reshape(bsz, s, N_HEADS_A, HEAD_DIM_A), ln_g, ln_b)
    v = v.reshape(bsz, n_chunks, CHUNK, N_HEADS_A, HEAD_DIM_A)
    causal = jnp.tril(jnp.ones((CHUNK, CHUNK), dtype=bool))
    w_masked = jnp.where(causal[None], w_s, jnp.zeros_like(w_s))
    mixed = jnp.einsum('hts,bcshd->bcthd', w_masked, v)
    mixed = mixed + jnp.transpose(b_s)[None, None, :, :, None]
    return u * mixed.reshape(bsz, s, D_A)


def short_gated_conv(b_gate, c_gate, xb, conv_w):
    s = xb.shape[1]
    z = c_gate * xb
    zp = jnp.pad(z, ((0, 0), (CONV_WIDTH - 1, 0), (0, 0)))
    conv = zp[:, 0:s] * conv_w[0] + zp[:, 1:s + 1] * conv_w[1] + zp[:, 2:s + 2] * conv_w[2]
    return b_gate * conv


def setup_inputs(seed: int = 0) -> dict:
    key = jax.random.key(seed)
    ks = jax.random.split(key, 24)

    def nrm(k, shape, scale):
        return scale * jax.random.normal(k, shape, jnp.float32)

    def gain(k, shape):
        return 1.0 + 0.02 * jax.random.normal(k, shape, jnp.float32)

    return {
        "x": nrm(ks[0], (BATCH, SEQ, D_MODEL), 1.0),
        "c": nrm(ks[1], (BATCH, D_MODEL), 1.0),
        "ada_w": nrm(ks[2], (DEPTH, D_MODEL, N_MOD * D_MODEL), 0.5 * D_MODEL ** -0.5),
        "ada_b": nrm(ks[3], (DEPTH, N_MOD * D_MODEL), 0.01),
        "norm_ffn1_g": gain(ks[4], (DEPTH, D_MODEL)),
        "ffn1_w_gu": nrm(ks[5], (DEPTH, D_MODEL, 2 * D_FF), D_MODEL ** -0.5),
        "ffn1_w_down": nrm(ks[6], (DEPTH, D_FF, D_MODEL), D_FF ** -0.5),
        "norm_mix_g": gain(ks[7], (DEPTH, D_MODEL)),
        "mix_w_in": nrm(ks[8], (DEPTH, D_MODEL, D_IN_PROJ), D_MODEL ** -0.5),
        "sgu_ln_g": gain(ks[9], (DEPTH, HEAD_DIM_A)),
        "sgu_ln_b": nrm(ks[10], (DEPTH, HEAD_DIM_A), 0.02),
        "sgu_w_s": nrm(ks[11], (DEPTH, N_HEADS_A, CHUNK, CHUNK), CHUNK ** -0.5),
        "sgu_b": gain(ks[12], (DEPTH, N_HEADS_A, CHUNK)),
        "conv_w": nrm(ks[13], (DEPTH, CONV_WIDTH, D_B), CONV_WIDTH ** -0.5),
        "out_norm_g": gain(ks[14], (DEPTH, D_MIX)),
        "mix_w_out": nrm(ks[15], (DEPTH, D_MIX, D_MODEL), D_MIX ** -0.5),
        "norm_ffn2_g": gain(ks[16], (DEPTH, D_MODEL)),
        "ffn2_w_gu": nrm(ks[17], (DEPTH, D_MODEL, 2 * D_FF), D_MODEL ** -0.5),
        "ffn2_w_down": nrm(ks[18], (DEPTH, D_FF, D_MODEL), D_FF ** -0.5),
        "final_norm_g": gain(ks[19], (D_MODEL,)),
    }


def reference(x, c, ada_w, ada_b, norm_ffn1_g, ffn1_w_gu, ffn1_w_down, norm_mix_g,
              mix_w_in, sgu_ln_g, sgu_ln_b, sgu_w_s, sgu_b, conv_w, out_norm_g,
              mix_w_out, norm_ffn2_g, ffn2_w_gu, ffn2_w_down, final_norm_g):
    c_act = jax.nn.silu(c)
    split_points = [D_A, 2 * D_A, 2 * D_A + D_B, 2 * D_A + 2 * D_B]
    for l in range(DEPTH):
        ada = jnp.einsum('bd,de->be', c_act, ada_w[l]) + ada_b[l]
        (sh1, sc1, g1, sh2, sc2, g2, sh3, sc3, g3) = jnp.split(ada, N_MOD, axis=-1)

        h = modulate(rms_norm(x, norm_ffn1_g[l]), sh1, sc1)
        x = x + 0.5 * g1[:, None, :] * swiglu_ffn(h, ffn1_w_gu[l], ffn1_w_down[l])

        h = modulate(rms_norm(x, norm_mix_g[l]), sh2, sc2)
        proj = jnp.einsum('bsd,de->bse', h, mix_w_in[l])
        u_a, v_a, b_gate, c_gate, xb = jnp.split(proj, split_points, axis=-1)
        y_a = chunked_sgu(jax.nn.gelu(u_a, approximate=False), jax.nn.gelu(v_a, approximate=False),
                          sgu_ln_g[l], sgu_ln_b[l], sgu_w_s[l], sgu_b[l])
        y_b = short_gated_conv(b_gate, c_gate, xb, conv_w[l])
        y = jnp.concatenate([rms_norm(y_a, out_norm_g[l, :D_A]),
                             rms_norm(y_b, out_norm_g[l, D_A:])], axis=-1)
        x = x + g2[:, None, :] * jnp.einsum('bse,ed->bsd', y, mix_w_out[l])

        h = modulate(rms_norm(x, norm_ffn2_g[l]), sh3, sc3)
        x = x + 0.5 * g3[:, None, :] * swiglu_ffn(h, ffn2_w_gu[l], ffn2_w_down[l])
    return rms_norm(x, final_norm_g)
```

```cpp
#include <hip/hip_runtime.h>
#include <hip/hip_cooperative_groups.h>
#include <cstdio>
#include <cstdint>
namespace cg = cooperative_groups;

#define LAS __attribute__((address_space(3)))
typedef unsigned short bf16_t;
typedef short bf16x8 __attribute__((ext_vector_type(8)));
typedef float f32x4 __attribute__((ext_vector_type(4)));
typedef float f32x2 __attribute__((ext_vector_type(2)));
typedef unsigned u32x4 __attribute__((ext_vector_type(4)));
typedef unsigned u32x2 __attribute__((ext_vector_type(2)));

constexpr int NTOK = 65536, DM = 1024, FF = 2816, NGU = 2 * FF, NIN = 2560, NPJ = 2048, NLAYER = 2, SEQ = 2048, NBATCH = 32, NADA = 9 * DM;
constexpr float EPS = 1e-6f;
constexpr int NTHREADS = 512, NWAVES = 8;
constexpr int STAGE_BYTES = 131072;
constexpr int LDS_BYTES = STAGE_BYTES + 8192 + 64;

constexpr size_t MiB = 1048576;
constexpr size_t WS_ADA = 0;
constexpr size_t WS_WSGU = 0x240000;
constexpr size_t WS_BAR = 0x2C0000;
constexpr size_t WS_SSQ = 3 * MiB;
constexpr size_t WS_GMB = 5 * MiB;
constexpr size_t WS_SHM = 6 * MiB;
constexpr size_t WS_BIAS = 7 * MiB;
constexpr size_t WS_WK1 = 16 * MiB;
constexpr size_t WK1_STRIDE = 27 * MiB, WK1_GU1 = 0, WK1_IN = 11 * MiB, WK1_GU2 = 16 * MiB;
constexpr size_t WS_WOTH = 70 * MiB;
constexpr size_t WOTH_STRIDE = 13 * MiB, WO_D1 = 0, WO_OUT = 5 * MiB + MiB / 2, WO_D2 = 7 * MiB + MiB / 2;
constexpr size_t WS_XN = 96 * MiB;
constexpr size_t WS_YB = 224 * MiB;
constexpr size_t WS_HB = 352 * MiB;
constexpr size_t WS_XB = 704 * MiB;
constexpr size_t WS_END = 832 * MiB;

__device__ __forceinline__ unsigned cvt_pk_bf16(float lo, float hi) { unsigned r; asm("v_cvt_pk_bf16_f32 %0, %1, %2" : "=v"(r) : "v"(lo), "v"(hi)); return r; }
__device__ __forceinline__ float bf_lo(unsigned w) { return __uint_as_float(w << 16); }
__device__ __forceinline__ float bf_hi(unsigned w) { return __uint_as_float(w & 0xffff0000u); }
template <int CTRL> __device__ __forceinline__ float dpp_get(float v) { return __builtin_bit_cast(float, __builtin_amdgcn_update_dpp(0, __builtin_bit_cast(int, v), CTRL, 0xf, 0xf, true)); }
__device__ __forceinline__ float sum_lanes8(float v) {
    v += dpp_get<0xB1>(v);
    v += dpp_get<0x4E>(v);
    v += dpp_get<0x141>(v);
    return v;
}
__device__ __forceinline__ float sum_rows(float v) {
    const unsigned x = __builtin_bit_cast(unsigned, v);
    const auto a = __builtin_amdgcn_permlane16_swap(x, x, false, false);
    const unsigned a0 = a[0], a1 = a[1];
    v = __builtin_bit_cast(float, a0) + __builtin_bit_cast(float, a1);
    const unsigned y = __builtin_bit_cast(unsigned, v);
    const auto b = __builtin_amdgcn_permlane32_swap(y, y, false, false);
    const unsigned b0 = b[0], b1 = b[1];
    return __builtin_bit_cast(float, b0) + __builtin_bit_cast(float, b1);
}
__device__ __forceinline__ float wave_sum(float v) { v = sum_lanes8(v); v += dpp_get<0x140>(v);   return sum_rows(v); }
__device__ __forceinline__ f32x2 gelu_pk(f32x2 v) {
    const f32x2 av = __builtin_elementwise_abs(v), d = av * 0.2316418882f + 1.0f;
    f32x2 t; t.x = __builtin_amdgcn_rcpf(d.x); t.y = __builtin_amdgcn_rcpf(d.y);
    f32x2 q = t * 0.5307027145f + (-0.7265760135f); q = q * t + 0.7107068705f; q = q * t + (-0.142248368f); q = q * t + 0.127414796f; q = q * t;
    const f32x2 s = (v * v) * (-0.72134752044f);
    f32x2 e; e.x = __builtin_amdgcn_exp2f(s.x); e.y = __builtin_amdgcn_exp2f(s.y);
    const f32x2 m = v * (q * e), r = v - m;
    f32x2 o; o.x = v.x < 0.f ? m.x : r.x; o.y = v.y < 0.f ? m.y : r.y; return o;
}
__device__ __forceinline__ f32x2 swiglu_pk(f32x2 g, f32x2 u) {
    const f32x2 t = g * (-1.44269504089f); f32x2 e; e.x = __builtin_amdgcn_exp2f(t.x); e.y = __builtin_amdgcn_exp2f(t.y);
    const f32x2 d = e + 1.0f; f32x2 r; r.x = __builtin_amdgcn_rcpf(d.x); r.y = __builtin_amdgcn_rcpf(d.y);
    return (g * r) * u;
}
__device__ __forceinline__ float silu_f(float g) { return g * __builtin_amdgcn_rcpf(1.0f + __builtin_amdgcn_exp2f(-1.44269504089f * g)); }

namespace pg8 {
constexpr int BM = 256, BK = 64, HALF = 128, HTB = HALF * BK * 2, NXCD = 8, WGM = 8;
__host__ __device__ __forceinline__ int lds_byte(int r, int c) { const int st = (r >> 4) * 2 + (c >> 5), rr = r & 15, cc = c & 31, ob = rr * 64 + cc * 2; return st * 1024 + (ob ^ (((ob >> 9) & 1) << 5)); }
__host__ __device__ __forceinline__ void stage_rc(int b, int& R, int& C) { const int st = b / 1024, sb = b % 1024, swz = sb ^ (((sb >> 9) & 1) << 5); R = (st >> 1) * 16 + swz / 64; C = (st & 1) * 32 + (swz % 64) / 2; }
__host__ __device__ __forceinline__ int perm32(int rho) { const int n = rho >> 4, i = rho & 15; return 8 * (i >> 2) + 4 * n + (i & 3); }

struct Unit { int pm, pn; };
template <int M, int N> struct StaticOrder {
    static constexpr int nM = M / BM, nN = N / BM, nwg = nM * nN;
    int G, c;
    __device__ __forceinline__ void init(int G_, int c_) { G = G_; c = c_; }
    __device__ __forceinline__ bool next(int i, Unit& u) const {
        const long L = (long)i * G + c; if (L >= nwg) return false;
        int wgid = (int)L; { constexpr int q = nwg / NXCD, r = nwg % NXCD; const int xcd = wgid % NXCD, off = wgid / NXCD; wgid = (xcd < r ? xcd * (q + 1) : r * (q + 1) + (xcd - r) * q) + off; }
        constexpr int nig = WGM * nN; const int gid = wgid / nig, fm = gid * WGM, gsz = (nM - fm) < WGM ? (nM - fm) : WGM;
        u.pm = fm + ((wgid % nig) % gsz); u.pn = (wgid % nig) / gsz; return true;
    }
};

struct EpiSwiglu {
    static constexpr bool PERM = true; static constexpr int RELAX = 1;
    bf16_t* H; const float* ssq; const float* bias;
    __device__ __forceinline__ void operator()(const f32x4 (&acc)[2][2][4][2], const Unit& u, int wr, int wc, int fr, int fq) const {
        const int row0 = u.pm * BM + wr * 64 + fr, col0 = u.pn * HALF + wc * 32 + 8 * fq;
        const float* bp = bias + (size_t)(u.pm >> 3) * NGU + u.pn * BM + wc * 32 + 8 * fq;
        float rs[2][4];
#pragma unroll
        for (int ai = 0; ai < 2; ++ai)
#pragma unroll
            for (int m = 0; m < 4; ++m) rs[ai][m] = ssq[row0 + ai * HALF + m * 16];
        const f32x4 bg0 = *(const f32x4*)bp, bg1 = *(const f32x4*)(bp + 4), bu0 = *(const f32x4*)(bp + HALF), bu1 = *(const f32x4*)(bp + HALF + 4);
#pragma unroll
        for (int ai = 0; ai < 2; ++ai)
#pragma unroll
            for (int m = 0; m < 4; ++m) rs[ai][m] = __builtin_amdgcn_rsqf(rs[ai][m] * (1.0f / DM) + EPS);
        asm volatile("" ::: "memory");
#pragma unroll
        for (int ai = 0; ai < 2; ++ai)
#pragma unroll
            for (int m = 0; m < 4; ++m) {
                const int row = row0 + ai * HALF + m * 16;
                const float rstd = rs[ai][m];
                bf16_t* rowp = H + (size_t)row * FF + col0;
                const f32x4 g0 = acc[ai][0][m][0] * rstd + bg0, g1 = acc[ai][0][m][1] * rstd + bg1, u0 = acc[ai][1][m][0] * rstd + bu0, u1 = acc[ai][1][m][1] * rstd + bu1;
                const f32x2 h0 = swiglu_pk((f32x2){g0[0], g0[1]}, (f32x2){u0[0], u0[1]}), h1 = swiglu_pk((f32x2){g0[2], g0[3]}, (f32x2){u0[2], u0[3]});
                const f32x2 h2 = swiglu_pk((f32x2){g1[0], g1[1]}, (f32x2){u1[0], u1[1]}), h3 = swiglu_pk((f32x2){g1[2], g1[3]}, (f32x2){u1[2], u1[3]});
                u32x4 w; w.x = cvt_pk_bf16(h0.x, h0.y); w.y = cvt_pk_bf16(h1.x, h1.y); w.z = cvt_pk_bf16(h2.x, h2.y); w.w = cvt_pk_bf16(h3.x, h3.y);
                *(u32x4*)rowp = w;
            }
    }
};
struct EpiProj {
    static constexpr bool PERM = true; static constexpr int RELAX = 1;
    bf16_t* O; const float* ssq; const float* bias;
    __device__ __forceinline__ void operator()(const f32x4 (&acc)[2][2][4][2], const Unit& u, int wr, int wc, int fr, int fq) const {
        const int row0 = u.pm * BM + wr * 64 + fr, slot0 = u.pn * BM + wc * 32 + 8 * fq;
        const bool act = u.pn < 4, pair = u.pn >= 6;
        const int col0 = pair ? 1536 + (u.pn - 6) * HALF + wc * 32 + 8 * fq : slot0;
        const float* bp = bias + (size_t)(u.pm >> 3) * NIN + slot0;
        f32x4 bv[2][2];
#pragma unroll
        for (int bj = 0; bj < 2; ++bj)
#pragma unroll
            for (int n = 0; n < 2; ++n) bv[bj][n] = *(const f32x4*)(bp + bj * HALF + 4 * n);
        float rs[2][4];
#pragma unroll
        for (int ai = 0; ai < 2; ++ai)
#pragma unroll
            for (int m = 0; m < 4; ++m) rs[ai][m] = ssq[row0 + ai * HALF + m * 16];
#pragma unroll
        for (int ai = 0; ai < 2; ++ai)
#pragma unroll
            for (int m = 0; m < 4; ++m) rs[ai][m] = __builtin_amdgcn_rsqf(rs[ai][m] * (1.0f / DM) + EPS);
        asm volatile("" ::: "memory");
#pragma unroll
        for (int ai = 0; ai < 2; ++ai)
#pragma unroll
            for (int m = 0; m < 4; ++m) {
                const int row = row0 + ai * HALF + m * 16;
                const float rstd = rs[ai][m];
                bf16_t* rowp = O + (size_t)row * NPJ + col0;
                if (pair) {
                    const f32x4 z0 = (acc[ai][0][m][0] * rstd + bv[0][0]) * (acc[ai][1][m][0] * rstd + bv[1][0]), z1 = (acc[ai][0][m][1] * rstd + bv[0][1]) * (acc[ai][1][m][1] * rstd + bv[1][1]);
                    u32x4 w; w.x = cvt_pk_bf16(z0[0], z0[1]); w.y = cvt_pk_bf16(z0[2], z0[3]); w.z = cvt_pk_bf16(z1[0], z1[1]); w.w = cvt_pk_bf16(z1[2], z1[3]);
                    *(u32x4*)rowp = w;
                } else {
#pragma unroll
                    for (int bj = 0; bj < 2; ++bj) {
                        f32x4 v0 = acc[ai][bj][m][0] * rstd + bv[bj][0], v1 = acc[ai][bj][m][1] * rstd + bv[bj][1];
                        if (act) { f32x2 a = gelu_pk((f32x2){v0[0], v0[1]}), b = gelu_pk((f32x2){v0[2], v0[3]}), c = gelu_pk((f32x2){v1[0], v1[1]}), d = gelu_pk((f32x2){v1[2], v1[3]});
                            v0 = (f32x4){a.x, a.y, b.x, b.y}; v1 = (f32x4){c.x, c.y, d.x, d.y}; }
                        u32x4 w; w.x = cvt_pk_bf16(v0[0], v0[1]); w.y = cvt_pk_bf16(v0[2], v0[3]); w.z = cvt_pk_bf16(v1[0], v1[1]); w.w = cvt_pk_bf16(v1[2], v1[3]);
                        *(u32x4*)(rowp + bj * HALF) = w;
                    }
                }
            }
    }
};
template <bool XIN_F32, bool XOUT_F32> struct EpiResid {
    static constexpr bool PERM = true; static constexpr int RELAX = 1;
    const void* xin; void* xout; const float* gate; float* ssq_next; const float* gm_next; bf16_t* xn; float scale; int pad_;
    __device__ __forceinline__ void operator()(const f32x4 (&acc)[2][2][4][2], const Unit& u, int wr, int wc, int fr, int fq) const {
        const void* const xin = this->xin; void* const xout = this->xout; const float* const gate = this->gate; const float scale = this->scale;
        float* const ssq_next = this->ssq_next; const float* const gm_next = this->gm_next; bf16_t* const xn = this->xn;
        const unsigned voff = (unsigned)(fr * DM + 8 * fq);
        const size_t uoff = (size_t)(u.pm * BM + wr * 64) * DM + (size_t)(u.pn * BM + wc * 32);
        const int b = u.pm >> 3, colq = u.pn * BM + wc * 32 + 8 * fq;
#pragma unroll
        for (int bj = 0; bj < 2; ++bj) {
            float ss[2][4];
#pragma unroll
            for (int ai = 0; ai < 2; ++ai)
#pragma unroll
                for (int m = 0; m < 4; ++m) ss[ai][m] = 0.f;
            u32x4 xb[2][4];
            if (!XIN_F32) {
#pragma unroll
                for (int ai = 0; ai < 2; ++ai)
#pragma unroll
                    for (int m = 0; m < 4; ++m) xb[ai][m] = *(const u32x4*)((const bf16_t*)xin + uoff + (size_t)((ai * HALF + m * 16) * DM + bj * HALF) + voff);
            }
            f32x4 gv[2], gm[2];
#pragma unroll
            for (int n = 0; n < 2; ++n) { gv[n] = *(const f32x4*)(gate + (size_t)b * NADA + colq + bj * HALF + 4 * n) * scale;
                gm[n] = gm_next ? *(const f32x4*)(gm_next + (size_t)b * DM + colq + bj * HALF + 4 * n) : (f32x4){0.f, 0.f, 0.f, 0.f}; }
#pragma unroll
            for (int ai = 0; ai < 2; ++ai) {
                f32x4 xv[4][2];
                if (XIN_F32) {
#pragma unroll
                    for (int m = 0; m < 4; ++m)
#pragma unroll
                        for (int n = 0; n < 2; ++n) xv[m][n] = *(const f32x4*)((const float*)xin + uoff + (size_t)((ai * HALF + m * 16) * DM + bj * HALF + 4 * n) + voff);
                }
#pragma unroll
                for (int m = 0; m < 4; ++m) {
                    const size_t eo = uoff + (size_t)((ai * HALF + m * 16) * DM + bj * HALF) + voff;
                    f32x4 x0, x1;
                    if (XIN_F32) { x0 = xv[m][0]; x1 = xv[m][1]; }
                    else { const u32x4 w = xb[ai][m]; x0 = (f32x4){bf_lo(w.x), bf_hi(w.x), bf_lo(w.y), bf_hi(w.y)}; x1 = (f32x4){bf_lo(w.z), bf_hi(w.z), bf_lo(w.w), bf_hi(w.w)}; }
                    const f32x4 y0 = x0 + gv[0] * acc[ai][bj][m][0], y1 = x1 + gv[1] * acc[ai][bj][m][1];
                    if (XOUT_F32) { *(f32x4*)((float*)xout + eo) = y0; *(f32x4*)((float*)xout + eo + 4) = y1; }
                    else { u32x4 w; w.x = cvt_pk_bf16(y0[0], y0[1]); w.y = cvt_pk_bf16(y0[2], y0[3]); w.z = cvt_pk_bf16(y1[0], y1[1]); w.w = cvt_pk_bf16(y1[2], y1[3]); *(u32x4*)((bf16_t*)xout + eo) = w; }
                    ss[ai][m] += (y0[0] * y0[0] + y0[1] * y0[1]) + (y0[2] * y0[2] + y0[3] * y0[3]) + (y1[0] * y1[0] + y1[1] * y1[1]) + (y1[2] * y1[2] + y1[3] * y1[3]);
                    if (gm_next) { const f32x4 z0 = y0 * gm[0], z1 = y1 * gm[1]; u32x4 w; w.x = cvt_pk_bf16(z0[0], z0[1]); w.y = cvt_pk_bf16(z0[2], z0[3]); w.z = cvt_pk_bf16(z1[0], z1[1]); w.w = cvt_pk_bf16(z1[2], z1[3]);
                        *(u32x4*)(xn + eo) = w; }
                }
                if (XIN_F32) asm volatile("" ::: "memory");
            }
#pragma unroll
            for (int ai = 0; ai < 2; ++ai)
#pragma unroll
                for (int m = 0; m < 4; ++m) { float s = ss[ai][m]; s = sum_rows(s);
                    if (fq == 0) atomicAdd(ssq_next + (u.pm * BM + wr * 64 + ai * HALF + m * 16 + fr), s); }
            asm volatile("" ::: "memory");
        }
    }
};
struct EpiBias {
    static constexpr bool PERM = true; static constexpr int RELAX = 0;
    float* bias0;
    __device__ __forceinline__ void operator()(const f32x4 (&acc)[2][2][4][2], const Unit& u, int wr, int wc, int fr, int fq) const {
        const int l = u.pn / 54, q = u.pn % 54, sub = q < 22 ? 0 : (q < 32 ? 1 : 2), pnl = q - (sub == 0 ? 0 : (sub == 1 ? 22 : 32)), j = 3 * l + sub, Nj = (sub == 1) ? NIN : NGU;
        float* bp = bias0 + (size_t)j * (MiB / 4) + pnl * BM + wc * 32 + 8 * fq;
#pragma unroll
        for (int ai = 0; ai < 2; ++ai)
#pragma unroll
            for (int m = 0; m < 4; ++m)
                if (4 * ai + 2 * wr + (m >> 1) == j) {
                    float* rp = bp + (size_t)(16 * (m & 1) + fr) * Nj;
#pragma unroll
                    for (int bj = 0; bj < 2; ++bj)
#pragma unroll
                        for (int n = 0; n < 2; ++n) *(f32x4*)(rp + bj * HALF + 4 * n) = acc[ai][bj][m][n];
                }
    }
};

template <int M, int N, int K, class Epi>
__device__ __forceinline__ void gemm_phase(LAS unsigned char* lds, const bf16_t* gA, const bf16_t* gBt, int G, int c, const Epi E) {
    StaticOrder<M, N> S; S.init(G, c);
    int tid = threadIdx.x; asm volatile("" : "+v"(tid));
    const int wid = __builtin_amdgcn_readfirstlane(tid >> 6), lane = tid & 63, wr = wid >> 2, wc = wid & 3, fr = lane & 15, fq = lane >> 4;
    constexpr int nt = K / BK;
    unsigned voffA[2], voffB[2];
#pragma unroll
    for (int i = 0; i < 2; ++i) { int R, C; stage_rc(tid * 16 + i * 8192, R, C); const int Rb = Epi::PERM ? ((R & ~31) + perm32(R & 31)) : R;
        voffA[i] = (unsigned)(R * K + C) * 2u; voffB[i] = (unsigned)(Rb * K + C) * 2u; }
    constexpr size_t kstep = (size_t)(BK * 2);
    constexpr size_t hstep = (size_t)HALF * K * 2;
    constexpr size_t tstep = 2 * hstep;
    const unsigned ldsw = (unsigned)wid * 1024u;
    const int aoff = lds_byte(wr * 64 + fr, fq * 8), boff = lds_byte(wc * 32 + fr, fq * 8);
#define PG8_SA(b, h) (((b) * 2 + (h)) * HTB)
#define PG8_SB(b, h) ((4 + (b) * 2 + (h)) * HTB)
#define PG8_STAGE(bufoff, gbase, voff) do { _Pragma("unroll") for (int _i = 0; _i < 2; ++_i) \
        __builtin_amdgcn_global_load_lds((const unsigned*)((const char*)(gbase) + (voff)[_i]), (LAS unsigned*)(lds + (bufoff) + ldsw + _i * 8192), 16, 0, 0); } while (0)
#define PG8_LDA(dst, b, h) do { _Pragma("unroll") for (int m = 0; m < 4; ++m) _Pragma("unroll") for (int k = 0; k < 2; ++k) dst[m][k] = *(const LAS bf16x8*)(lds + PG8_SA(b, h) + aoff + m * 2048 + k * 1024); } while (0)
#define PG8_LDB(dst, b, h) do { _Pragma("unroll") for (int n = 0; n < 2; ++n) _Pragma("unroll") for (int k = 0; k < 2; ++k) dst[n][k] = *(const LAS bf16x8*)(lds + PG8_SB(b, h) + boff + n * 2048 + k * 1024); } while (0)
#define PG8_MMA(ai, bj, At, Bt) do { __builtin_amdgcn_s_setprio(1); _Pragma("unroll") for (int m = 0; m < 4; ++m) _Pragma("unroll") for (int n = 0; n < 2; ++n) _Pragma("unroll") for (int k = 0; k < 2; ++k) \
        acc[ai][bj][m][n] = __builtin_amdgcn_mfma_f32_16x16x32_bf16(Bt[n][k], At[m][k], acc[ai][bj][m][n], 0, 0, 0); __builtin_amdgcn_s_setprio(0); } while (0)
#define PG8_WAIT_V(n) asm volatile("s_waitcnt vmcnt(" #n ")" ::: "memory")
#define PG8_WAIT_L(n) asm volatile("s_waitcnt lgkmcnt(" #n ")" ::: "memory")
#define PG8_WAIT_V8_UNLESS(flag) asm volatile("s_cmp_lg_u32 %0, 0\n\ts_cbranch_scc1 .Lpg8w%=\n\ts_waitcnt vmcnt(8)\n.Lpg8w%=:" :: "s"(flag) : "memory", "scc")
#define PG8_BAR __builtin_amdgcn_s_barrier()
#define PG8_SCHED __builtin_amdgcn_sched_barrier(0)
    Unit cur, nxt; int ui = 0;
    if (!S.next(0, cur)) return;
    f32x4 acc[2][2][4][2];
#pragma unroll
    for (int a = 0; a < 2; ++a)
#pragma unroll
        for (int b = 0; b < 2; ++b)
#pragma unroll
            for (int m = 0; m < 4; ++m)
#pragma unroll
                for (int n = 0; n < 2; ++n) acc[a][b][m][n] = (f32x4){0.f, 0.f, 0.f, 0.f};
    bf16x8 At[4][2], B0[2][2], B1[2][2];
    const char* cA = (const char*)gA + (size_t)cur.pm * tstep; const char* cB = (const char*)gBt + (size_t)cur.pn * tstep;
    PG8_STAGE(PG8_SB(0, 0), cB, voffB); PG8_STAGE(PG8_SB(0, 1), cB + hstep, voffB); PG8_STAGE(PG8_SA(0, 0), cA, voffA); PG8_STAGE(PG8_SA(0, 1), cA + hstep, voffA);
    if (wr == 1) PG8_BAR;
    PG8_WAIT_V(2); PG8_BAR;
    PG8_STAGE(PG8_SB(1, 0), cB + kstep, voffB); PG8_STAGE(PG8_SA(1, 0), cA + kstep, voffA); PG8_STAGE(PG8_SB(1, 1), cB + hstep + kstep, voffB);
    PG8_WAIT_V(6); PG8_BAR;
    for (;;) {
        const bool has_next = S.next(ui + 1, nxt);
        const char* nA = has_next ? (const char*)gA + (size_t)nxt.pm * tstep : cA; const char* nB = has_next ? (const char*)gBt + (size_t)nxt.pn * tstep : cB;
        for (int t = 0; t < nt; t += 2) {
            const bool last = (t == nt - 2);
            const char* a1 = cA + (size_t)(t + 1) * kstep;
            const char* a2 = last ? nA : cA + (size_t)(t + 2) * kstep; const char* b2 = last ? nB : cB + (size_t)(t + 2) * kstep;
            const char* a3 = a2 + kstep; const char* b3 = b2 + kstep;
            int relaxv = (Epi::RELAX != 0 && t == 0 && ui > 0) ? 1 : 0; asm volatile("" : "+v"(relaxv)); const int relax = __builtin_amdgcn_readfirstlane(relaxv);
            PG8_LDB(B0, 0, 0); PG8_LDB(B1, 0, 1); PG8_SCHED; PG8_LDA(At, 0, 0); PG8_STAGE(PG8_SA(1, 1), a1 + hstep, voffA);
            PG8_WAIT_V8_UNLESS(relax); PG8_WAIT_L(0); PG8_BAR; PG8_MMA(0, 0, At, B0); PG8_MMA(0, 1, At, B1); PG8_BAR; PG8_SCHED;
            PG8_LDA(At, 0, 1); PG8_STAGE(PG8_SB(0, 0), b2, voffB); PG8_STAGE(PG8_SB(0, 1), b2 + hstep, voffB); PG8_STAGE(PG8_SA(0, 0), a2, voffA);
            PG8_WAIT_V8_UNLESS(relax); PG8_WAIT_L(0); PG8_BAR; PG8_MMA(1, 0, At, B0); PG8_MMA(1, 1, At, B1); PG8_BAR; PG8_SCHED;
            PG8_LDB(B0, 1, 0); PG8_LDB(B1, 1, 1); PG8_SCHED; PG8_LDA(At, 1, 0); PG8_STAGE(PG8_SA(0, 1), a2 + hstep, voffA);
            PG8_WAIT_V8_UNLESS(relax); PG8_WAIT_L(0); PG8_BAR; PG8_MMA(0, 0, At, B0); PG8_MMA(0, 1, At, B1); PG8_BAR; PG8_SCHED;
            PG8_LDA(At, 1, 1); PG8_STAGE(PG8_SB(1, 0), b3, voffB); PG8_STAGE(PG8_SB(1, 1), b3 + hstep, voffB); PG8_STAGE(PG8_SA(1, 0), a3, voffA);
            PG8_WAIT_V(8); PG8_WAIT_L(0); PG8_BAR; PG8_MMA(1, 0, At, B0); PG8_MMA(1, 1, At, B1); PG8_BAR; PG8_SCHED;
        }
        if (Epi::RELAX != 0 && has_next) PG8_STAGE(PG8_SA(1, 1), nA + kstep + hstep, voffA);
        if (wr == 0) PG8_BAR;
        E(acc, cur, wr, wc, fr, fq);
        if (!has_next) break;
#pragma unroll
        for (int a = 0; a < 2; ++a)
#pragma unroll
            for (int b = 0; b < 2; ++b)
#pragma unroll
                for (int m = 0; m < 4; ++m)
#pragma unroll
                    for (int n = 0; n < 2; ++n) acc[a][b][m][n] = (f32x4){0.f, 0.f, 0.f, 0.f};
        cur = nxt; cA = nA; cB = nB; ++ui;
        if (wr == 1) PG8_BAR;
    }
    PG8_WAIT_V(0);
    PG8_BAR;
#undef PG8_SA
#undef PG8_SB
#undef PG8_STAGE
#undef PG8_LDA
#undef PG8_LDB
#undef PG8_MMA
#undef PG8_WAIT_V
#undef PG8_WAIT_L
#undef PG8_WAIT_V8_UNLESS
#undef PG8_BAR
#undef PG8_SCHED
}
}

#define XB_TMO      128
#define XB_XCNT(j)  (256  + 64 * (j))
#define XB_XSUB(j)  (1280 + 64 * (j))
#define XB_XGEN(j)  (2304 + 64 * (j))
#define XB_TOP      3328
#define XB_TOPGEN   3392
#define XCD_BAR_WORDS 3456
#define XB_SPIN_CAP (1u << 20)
__device__ __forceinline__ unsigned xb_ld(unsigned* p)              { return __hip_atomic_load(p, __ATOMIC_RELAXED, __HIP_MEMORY_SCOPE_AGENT); }
__device__ __forceinline__ unsigned xb_add(unsigned* p, unsigned v) { return __hip_atomic_fetch_add(p, v, __ATOMIC_RELAXED, __HIP_MEMORY_SCOPE_AGENT); }
__device__ __forceinline__ unsigned xb_xcc_id() { return (unsigned)__builtin_amdgcn_s_getreg((3 << 11) | 20) & 0xFu; }
#define XB_SPIN(cond, bar) do { unsigned _sp = 0; while (cond) { __builtin_amdgcn_s_sleep(1); \
    if ((++_sp & 255u) == 0u) { if (xb_ld(&(bar)[XB_TMO])) break; if (_sp > XB_SPIN_CAP) { atomicAdd(&(bar)[XB_TMO], 1u); break; } } } } while (0)
struct XcdBarrier { unsigned* bar; unsigned x; volatile LAS unsigned* st; };
__device__ __forceinline__ XcdBarrier xcd_barrier_post(unsigned* bar, volatile LAS unsigned* st) {
    XcdBarrier b; b.bar = bar; b.x = xb_xcc_id(); b.st = st;
    if (threadIdx.x == 0) (void)xb_add(&bar[XB_XCNT(b.x)], 1u);
    return b;
}
__device__ __forceinline__ void xcd_barrier_complete(unsigned* bar, unsigned x, unsigned& nloc, unsigned& nx) {
    const unsigned G = gridDim.x * gridDim.y * gridDim.z;
    unsigned sum, cnt, mine, sp = 0u;
    for (;;) {
        sum = 0u; cnt = 0u; mine = 0u;
#pragma unroll
        for (unsigned j = 0; j < 16; ++j) { const unsigned c = xb_ld(&bar[XB_XCNT(j)]); sum += c; cnt += (c > 0u) ? 1u : 0u; mine = (j == x) ? c : mine; }
        if (sum == G) break;
        __builtin_amdgcn_s_sleep(1);
        if ((++sp & 255u) == 0u) { if (xb_ld(&bar[XB_TMO])) break; if (sp > XB_SPIN_CAP) { atomicAdd(&bar[XB_TMO], 1u); break; } }
    }
    nloc = mine > 0u ? mine : 1u; nx = cnt > 0u ? cnt : 1u;
}
__device__ __forceinline__ void xcd_barrier(const XcdBarrier& b) {
    asm volatile("s_waitcnt vmcnt(0)" ::: "memory");
    __syncthreads();
    if (threadIdx.x == 0) {
        unsigned* bar = b.bar;
        __builtin_amdgcn_s_waitcnt(0);
        unsigned nloc = b.st[0], nx = b.st[1];
        if (nloc == 0u) { xcd_barrier_complete(bar, b.x, nloc, nx); b.st[0] = nloc; b.st[1] = nx; }
        const unsigned old = xb_add(&bar[XB_XSUB(b.x)], 1u);
        const unsigned gen = old / nloc;
        if (old + 1u == (gen + 1u) * nloc) {
            __builtin_amdgcn_fence(__ATOMIC_RELEASE, "agent");
            asm volatile("s_waitcnt vmcnt(0)" ::: "memory");
            const unsigned og = xb_add(&bar[XB_TOP], 1u);
            const unsigned tg = og / nx;
            if (og + 1u == (tg + 1u) * nx) xb_add(&bar[XB_TOPGEN], 1u);
            else XB_SPIN(xb_ld(&bar[XB_TOPGEN]) == tg, bar);
            __builtin_amdgcn_fence(__ATOMIC_ACQUIRE, "agent");
            xb_add(&bar[XB_XGEN(b.x)], 1u);
            asm volatile("s_waitcnt vmcnt(0)" ::: "memory");
        } else {
            XB_SPIN(xb_ld(&bar[XB_XGEN(b.x)]) == gen, bar);
            __builtin_amdgcn_fence(__ATOMIC_ACQUIRE, "agent");
            asm volatile("s_waitcnt vmcnt(0)" ::: "memory");
        }
    }
    __syncthreads();
}

template <int MODE>
__device__ __forceinline__ void transpose_item(const float* W, int K, int N, bf16_t* WT, LAS float* scr, int item, int lane) {
    const int nblk = N / 32, kb = item / nblk, nb = item % nblk, k0 = 64 * kb, n0 = 32 * nb;
    int nrow = n0;
    if (MODE == 1) { const int nn = (n0 < FF) ? n0 : n0 - FF; nrow = ((nn >> 7) << 8) + (nn & 127) + ((n0 < FF) ? 0 : 128); }
    if (MODE == 2 && n0 >= 1536) { const int nn = (n0 < 2048) ? n0 - 1536 : n0 - 2048; nrow = 1536 + ((nn >> 7) << 8) + (nn & 127) + ((n0 < 2048) ? 0 : 128); }
    { float tv[32]; const float* wp = W + (size_t)(k0 + (lane >> 5)) * N + n0 + (lane & 31);
#pragma unroll
      for (int i = 0; i < 32; ++i) tv[i] = wp[(size_t)(2 * i) * N];
#pragma unroll
      for (int i = 0; i < 32; ++i) scr[(2 * i + (lane >> 5)) * 33 + (lane & 31)] = tv[i]; }
    asm volatile("s_waitcnt lgkmcnt(0)" ::: "memory");
    const int c = lane & 7;
#pragma unroll
    for (int j = 0; j < 4; ++j) { const int n = (lane >> 3) + 8 * j; const LAS float* s = scr + (8 * c) * 33 + n;
        u32x4 o; o.x = cvt_pk_bf16(s[0 * 33], s[1 * 33]); o.y = cvt_pk_bf16(s[2 * 33], s[3 * 33]); o.z = cvt_pk_bf16(s[4 * 33], s[5 * 33]); o.w = cvt_pk_bf16(s[6 * 33], s[7 * 33]);
        *(u32x4*)(WT + (size_t)(nrow + n) * K + k0 + 8 * c) = o; }
    asm volatile("s_waitcnt lgkmcnt(0)" ::: "memory");
}

struct Args { const float* in[20]; float* out; unsigned char* ws; };

__device__ __forceinline__ void prologue(LAS unsigned char* lds, const Args& a, int G, int bid, int tid, int wid, int lane) {
    unsigned char* ws = a.ws;
    LAS float* scr = (LAS float*)(lds + wid * 16384);
    const int gw = bid * NWAVES + wid, NGW = G * NWAVES;
    constexpr int I_GU = (DM / 64) * (NGU / 32), I_D = (FF / 64) * (DM / 32), I_IN = (DM / 64) * (NIN / 32), I_OUT = (DM / 64) * (DM / 32);
    constexpr int I_LAYER = 2 * I_GU + 2 * I_D + I_IN + I_OUT;
    for (int it = gw; it < NLAYER * I_LAYER; it += NGW) {
        const int l = it / I_LAYER; int r = it % I_LAYER;
        unsigned char* wk = ws + WS_WK1 + (size_t)l * WK1_STRIDE; unsigned char* wo = ws + WS_WOTH + (size_t)l * WOTH_STRIDE;
        if (r < I_GU) { transpose_item<1>(a.in[5] + (size_t)l * DM * NGU, DM, NGU, (bf16_t*)(wk + WK1_GU1), scr, r, lane); continue; } r -= I_GU;
        if (r < I_GU) { transpose_item<1>(a.in[17] + (size_t)l * DM * NGU, DM, NGU, (bf16_t*)(wk + WK1_GU2), scr, r, lane); continue; } r -= I_GU;
        if (r < I_D) { transpose_item<0>(a.in[6] + (size_t)l * FF * DM, FF, DM, (bf16_t*)(wo + WO_D1), scr, r, lane); continue; } r -= I_D;
        if (r < I_D) { transpose_item<0>(a.in[18] + (size_t)l * FF * DM, FF, DM, (bf16_t*)(wo + WO_D2), scr, r, lane); continue; } r -= I_D;
        if (r < I_IN) { transpose_item<2>(a.in[8] + (size_t)l * DM * NIN, DM, NIN, (bf16_t*)(wk + WK1_IN), scr, r, lane); continue; } r -= I_IN;
        transpose_item<0>(a.in[15] + (size_t)l * DM * DM, DM, DM, (bf16_t*)(wo + WO_OUT), scr, r, lane);
    }
    { f32x4* z = (f32x4*)(ws + WS_SSQ) + NTOK / 4; for (int i = bid * NTHREADS + tid; i < 6 * NTOK / 4; i += G * NTHREADS) z[i] = (f32x4){0.f, 0.f, 0.f, 0.f}; }
    {
        const float* wsrc = a.in[11]; bf16_t* wdst = (bf16_t*)(ws + WS_WSGU);
        for (int i = bid * NTHREADS + tid; i < NLAYER * 8 * 128 * 128 / 2; i += G * NTHREADS) {
            const int e = 2 * i, s = e & 127, t = (e >> 7) & 127;
            const f32x2 v = *(const f32x2*)(wsrc + e);
            ((unsigned*)wdst)[i] = cvt_pk_bf16(s <= t ? v.x : 0.f, (s + 1) <= t ? v.y : 0.f);
        }
    }
    __syncthreads();
    {
        const float* c = a.in[1]; const float* aw = a.in[2]; const float* ab = a.in[3]; float* ada = (float*)(ws + WS_ADA);
        for (int it = bid; it < NLAYER * (NADA / 64); it += G) {
            const int l = it / (NADA / 64), e0 = (it % (NADA / 64)) * 64;
            for (int idx = lane; idx < 4096; idx += 64) { const int dd = idx >> 5, b = idx & 31; const float cv = c[b * DM + 128 * wid + dd]; scr[idx] = cv / (1.0f + __expf(-cv)); }
            asm volatile("s_waitcnt lgkmcnt(0)" ::: "memory");
            float acc[32];
#pragma unroll
            for (int b = 0; b < 32; ++b) acc[b] = 0.f;
            const float* wp = aw + ((size_t)l * DM + 128 * wid) * NADA + e0 + lane;
            for (int d0 = 0; d0 < 128; d0 += 16) {
                float wv[16];
#pragma unroll
                for (int j = 0; j < 16; ++j) wv[j] = wp[(size_t)(d0 + j) * NADA];
#pragma unroll
                for (int j = 0; j < 16; ++j) {
#pragma unroll
                    for (int q = 0; q < 8; ++q) { const f32x4 cv = *(const LAS f32x4*)(scr + (d0 + j) * 32 + 4 * q);
                        acc[4 * q + 0] += wv[j] * cv[0]; acc[4 * q + 1] += wv[j] * cv[1]; acc[4 * q + 2] += wv[j] * cv[2]; acc[4 * q + 3] += wv[j] * cv[3]; }
                }
            }
            __syncthreads();
            LAS float* red = (LAS float*)lds;
#pragma unroll
            for (int b = 0; b < 32; ++b) red[(wid * 32 + b) * 64 + lane] = acc[b];
            __syncthreads();
            for (int o = tid; o < 2048; o += NTHREADS) { const int b = o >> 6, e = o & 63; float s = ab[l * NADA + e0 + e];
#pragma unroll
                for (int w = 0; w < 8; ++w) s += red[(w * 32 + b) * 64 + e];
                ada[(size_t)(l * NBATCH + b) * NADA + e0 + e] = s; }
            __syncthreads();
        }
    }
}

__device__ __forceinline__ void norm0_phase(const float* x, bf16_t* xn, float* ssq, const float* gn, const float* sc, int gw, int NGW, int lane) {
    asm volatile("" : "+v"(lane));
    for (int rg = gw; rg < NTOK / 32; rg += NGW) {
        const int b = rg >> 6;
        f32x4 gm[4];
#pragma unroll
        for (int j = 0; j < 4; ++j) { const f32x4 g = *(const f32x4*)(gn + 256 * j + 4 * lane); const f32x4 s = *(const f32x4*)(sc + (size_t)b * NADA + 256 * j + 4 * lane); gm[j] = g * (s + 1.0f); }
        const float* xr = x + (size_t)rg * 32 * DM + 4 * lane;
        bf16_t* orow = xn + (size_t)rg * 32 * DM + 4 * lane;
        f32x4 v[4], nv[4];
#pragma unroll
        for (int j = 0; j < 4; ++j) nv[j] = *(const f32x4*)(xr + 256 * j);
        for (int r = 0; r < 32; ++r) {
#pragma unroll
            for (int j = 0; j < 4; ++j) v[j] = nv[j];
            if (r + 1 < 32) {
#pragma unroll
                for (int j = 0; j < 4; ++j) nv[j] = *(const f32x4*)(xr + (size_t)(r + 1) * DM + 256 * j);
            }
            float ss = 0.f;
#pragma unroll
            for (int j = 0; j < 4; ++j) ss += (v[j][0] * v[j][0] + v[j][1] * v[j][1]) + (v[j][2] * v[j][2] + v[j][3] * v[j][3]);
            ss = wave_sum(ss);
            if (lane == 0) ssq[rg * 32 + r] = ss;
#pragma unroll
            for (int j = 0; j < 4; ++j) { const f32x4 o = v[j] * gm[j]; u32x2 w; w.x = cvt_pk_bf16(o[0], o[1]); w.y = cvt_pk_bf16(o[2], o[3]);
                *(u32x2*)(orow + (size_t)r * DM + 256 * j) = w; }
        }
    }
}
__device__ __forceinline__ void final_norm_phase(float* x, const float* ssq, const float* gn, int gw, int NGW, int lane) {
    asm volatile("" : "+v"(lane));
    f32x4 gm[4];
#pragma unroll
    for (int j = 0; j < 4; ++j) gm[j] = *(const f32x4*)(gn + 256 * j + 4 * lane);
    for (int rg = gw; rg < NTOK / 32; rg += NGW) {
        float* xr = x + (size_t)rg * 32 * DM + 4 * lane;
#pragma unroll 4
        for (int r = 0; r < 32; ++r) {
            const float rstd = __builtin_amdgcn_rsqf(ssq[rg * 32 + r] * (1.0f / DM) + EPS);
#pragma unroll
            for (int j = 0; j < 4; ++j) { float* p = xr + (size_t)r * DM + 256 * j; *(f32x4*)p = *(const f32x4*)p * rstd * gm[j]; }
        }
    }
}

__device__ __forceinline__ void mixer_phase(LAS unsigned char* lds, const bf16_t* PROJ, bf16_t* Y, const bf16_t* Wsb, const float* sgub, const float* lng, const float* lnb,
                                            const float* convw, const float* og, int G, int bid, int wid, int lane) {
    asm volatile("" : "+v"(lane));
    const int fr = lane & 15, fq = lane >> 4, ch8 = lane & 7, rgrp = lane >> 3;
    LAS unsigned char* vT = lds + wid * 16384;
    LAS float* ssq = (LAS float*)(lds + STAGE_BYTES);
    float lg[8], lb[8], ogA[16], w0[8], w1[8], w2[8], ogB[8];
#pragma unroll
    for (int i = 0; i < 8; ++i) { lg[i] = lng[8 * ch8 + i]; lb[i] = lnb[8 * ch8 + i]; w0[i] = convw[8 * lane + i]; w1[i] = convw[512 + 8 * lane + i]; w2[i] = convw[1024 + 8 * lane + i]; ogB[i] = og[512 + 8 * lane + i]; }
#pragma unroll
    for (int i = 0; i < 16; ++i) ogA[i] = og[64 * wid + 16 * fq + i];
    int par = 0;
    for (int ch = bid; ch < NTOK / 128; ch += G, par ^= 1) {
        const size_t r0 = (size_t)ch * 128;
        {
            const size_t r = r0 + 16 * wid;
            const bf16_t* pb = PROJ + r * NPJ + 1024 + 8 * lane;
            float zm1[8], zm2[8];
            const bool first = ((r0 & (SEQ - 1)) == 0) && (wid == 0);
            if (!first) {
                const u32x4 z1v = *(const u32x4*)(pb - NPJ + 512), z2v = *(const u32x4*)(pb - 2 * NPJ + 512);
#pragma unroll
                for (int q = 0; q < 4; ++q) { zm1[2 * q] = bf_lo(z1v[q]); zm1[2 * q + 1] = bf_hi(z1v[q]); zm2[2 * q] = bf_lo(z2v[q]); zm2[2 * q + 1] = bf_hi(z2v[q]); }
            } else {
#pragma unroll
                for (int i = 0; i < 8; ++i) { zm1[i] = 0.f; zm2[i] = 0.f; }
            }
#pragma unroll 8
            for (int t = 0; t < 16; ++t) {
                const u32x4 bgv = *(const u32x4*)(pb + (size_t)t * NPJ), zv = *(const u32x4*)(pb + (size_t)t * NPJ + 512);
                float y[8]; float ss = 0.f;
#pragma unroll
                for (int q = 0; q < 4; ++q) {
                    const float z0 = bf_lo(zv[q]), z1 = bf_hi(zv[q]);
                    y[2 * q] = bf_lo(bgv[q]) * (w0[2 * q] * zm2[2 * q] + w1[2 * q] * zm1[2 * q] + w2[2 * q] * z0);
                    y[2 * q + 1] = bf_hi(bgv[q]) * (w0[2 * q + 1] * zm2[2 * q + 1] + w1[2 * q + 1] * zm1[2 * q + 1] + w2[2 * q + 1] * z1);
                    zm2[2 * q] = zm1[2 * q]; zm1[2 * q] = z0; zm2[2 * q + 1] = zm1[2 * q + 1]; zm1[2 * q + 1] = z1;
                    ss += y[2 * q] * y[2 * q] + y[2 * q + 1] * y[2 * q + 1];
                }
                const float rstd = __builtin_amdgcn_rsqf(wave_sum(ss) * (1.0f / 512.0f) + EPS);
                u32x4 o;
#pragma unroll
                for (int q = 0; q < 4; ++q) o[q] = cvt_pk_bf16(y[2 * q] * rstd * ogB[2 * q], y[2 * q + 1] * rstd * ogB[2 * q + 1]);
                *(u32x4*)(Y + (r + t) * DM + 512 + 8 * lane) = o;
            }
        }
        {
            const bf16_t* pv = PROJ + r0 * NPJ + 512 + 64 * wid + 8 * ch8;
#pragma unroll 8
            for (int it = 0; it < 16; ++it) {
                const int s = 8 * it + rgrp;
                const u32x4 vv = *(const u32x4*)(pv + (size_t)s * NPJ);
                float x[8]; float sm = 0.f;
#pragma unroll
                for (int q = 0; q < 4; ++q) { x[2 * q] = bf_lo(vv[q]); x[2 * q + 1] = bf_hi(vv[q]); sm += x[2 * q] + x[2 * q + 1]; }
                sm = sum_lanes8(sm);
                const float mu = sm * (1.0f / 64.0f); float sq = 0.f;
#pragma unroll
                for (int i = 0; i < 8; ++i) { x[i] -= mu; sq += x[i] * x[i]; }
                sq = sum_lanes8(sq);
                const float rs = __builtin_amdgcn_rsqf(sq * (1.0f / 64.0f) + EPS);
#pragma unroll
                for (int i = 0; i < 8; i += 2) {
                    const unsigned pk = cvt_pk_bf16(x[i] * rs * lg[i] + lb[i], x[i + 1] * rs * lg[i + 1] + lb[i + 1]);
                    const int qq = ch8 >> 1, dt = ((ch8 & 1) << 1) | (i >> 2), j = i & 3, lo15 = 4 * qq + j, rho = 16 * dt + lo15;
                    const int sw0 = (rho & 15) ^ (((rho >> 3) & 1) | (((rho >> 5) & 1) << 1)), sw1 = ((rho + 1) & 15) ^ ((((rho + 1) >> 3) & 1) | ((((rho + 1) >> 5) & 1) << 1));
                    *(LAS unsigned short*)(vT + rho * 256 + ((((s >> 3) ^ sw0) & 15) << 4) + (s & 7) * 2) = (unsigned short)(pk & 0xffffu);
                    *(LAS unsigned short*)(vT + (rho + 1) * 256 + ((((s >> 3) ^ sw1) & 15) << 4) + (s & 7) * 2) = (unsigned short)(pk >> 16);
                }
            }
            asm volatile("s_waitcnt lgkmcnt(0)" ::: "memory");
        }
        unsigned ypk[8][4][2];
        {
            const bf16_t* wb = Wsb + (size_t)wid * 128 * 128;
            const bf16_t* pu = PROJ + r0 * NPJ + 64 * wid + 16 * fq;
#pragma unroll
            for (int i = 0; i < 8; ++i) {
                f32x4 acc[4];
#pragma unroll
                for (int dt = 0; dt < 4; ++dt) acc[dt] = (f32x4){0.f, 0.f, 0.f, 0.f};
                const int t = 16 * i + fr;
                const u32x4 ua = *(const u32x4*)(pu + (size_t)t * NPJ), ub = *(const u32x4*)(pu + (size_t)t * NPJ + 8);
                const float bias = sgub[wid * 128 + t];
#pragma unroll
                for (int ks = 0; ks <= i / 2; ++ks) {
                    const bf16x8 wf = *(const bf16x8*)(wb + (size_t)t * 128 + 32 * ks + 8 * fq);
#pragma unroll
                    for (int dt = 0; dt < 4; ++dt) {
                        const bf16x8 vf = *(const LAS bf16x8*)(vT + (16 * dt + fr) * 256 + ((((4 * ks + fq) ^ (fr ^ ((fr >> 3) | ((dt >> 1) << 1)))) & 15) << 4));
                        acc[dt] = __builtin_amdgcn_mfma_f32_16x16x32_bf16(vf, wf, acc[dt], 0, 0, 0);
                    }
                }
                float ss = 0.f;
#pragma unroll
                for (int dt = 0; dt < 4; ++dt) {
                    const unsigned uw0 = (dt < 2) ? ua[2 * (dt & 1)] : ub[2 * (dt & 1)], uw1 = (dt < 2) ? ua[2 * (dt & 1) + 1] : ub[2 * (dt & 1) + 1];
                    const float y0 = bf_lo(uw0) * (acc[dt][0] + bias), y1 = bf_hi(uw0) * (acc[dt][1] + bias), y2 = bf_lo(uw1) * (acc[dt][2] + bias), y3 = bf_hi(uw1) * (acc[dt][3] + bias);
                    ss += (y0 * y0 + y1 * y1) + (y2 * y2 + y3 * y3);
                    ypk[i][dt][0] = cvt_pk_bf16(y0, y1); ypk[i][dt][1] = cvt_pk_bf16(y2, y3);
                }
                ss = sum_rows(ss);
                ssq[(par * 8 + wid) * 128 + t] = ss;
            }
        }
        __syncthreads();
        {
#pragma unroll
            for (int i = 0; i < 8; ++i) {
                const int t = 16 * i + fr; float tot = 0.f;
#pragma unroll
                for (int h = 0; h < 8; ++h) tot += ssq[(par * 8 + h) * 128 + t];
                const float rstd = __builtin_amdgcn_rsqf(tot * (1.0f / 512.0f) + EPS);
                u32x4 o0, o1;
                o0.x = cvt_pk_bf16(bf_lo(ypk[i][0][0]) * rstd * ogA[0], bf_hi(ypk[i][0][0]) * rstd * ogA[1]); o0.y = cvt_pk_bf16(bf_lo(ypk[i][0][1]) * rstd * ogA[2], bf_hi(ypk[i][0][1]) * rstd * ogA[3]);
                o0.z = cvt_pk_bf16(bf_lo(ypk[i][1][0]) * rstd * ogA[4], bf_hi(ypk[i][1][0]) * rstd * ogA[5]); o0.w = cvt_pk_bf16(bf_lo(ypk[i][1][1]) * rstd * ogA[6], bf_hi(ypk[i][1][1]) * rstd * ogA[7]);
                o1.x = cvt_pk_bf16(bf_lo(ypk[i][2][0]) * rstd * ogA[8], bf_hi(ypk[i][2][0]) * rstd * ogA[9]); o1.y = cvt_pk_bf16(bf_lo(ypk[i][2][1]) * rstd * ogA[10], bf_hi(ypk[i][2][1]) * rstd * ogA[11]);
                o1.z = cvt_pk_bf16(bf_lo(ypk[i][3][0]) * rstd * ogA[12], bf_hi(ypk[i][3][0]) * rstd * ogA[13]); o1.w = cvt_pk_bf16(bf_lo(ypk[i][3][1]) * rstd * ogA[14], bf_hi(ypk[i][3][1]) * rstd * ogA[15]);
                bf16_t* yp = Y + (r0 + t) * DM + 64 * wid + 16 * fq;
                *(u32x4*)yp = o0; *(u32x4*)(yp + 8) = o1;
            }
        }
    }
    __syncthreads();
}

template <int L>
__device__ __forceinline__ void layer(LAS unsigned char* lds, const Args& a, const XcdBarrier& bar, int G, int bid, int wid, int lane) {
    unsigned char* ws = a.ws; float* out = a.out;
    bf16_t* XN = (bf16_t*)(ws + WS_XN); bf16_t* HB = (bf16_t*)(ws + WS_HB); bf16_t* YB = (bf16_t*)(ws + WS_YB);
    const float* ada = (const float*)(ws + WS_ADA) + (size_t)L * NBATCH * NADA;
    const unsigned char* wk = ws + WS_WK1 + (size_t)L * WK1_STRIDE; const unsigned char* wo = ws + WS_WOTH + (size_t)L * WOTH_STRIDE;
    bf16_t* XB = (bf16_t*)(ws + WS_XB);
    float* ssq = (float*)(ws + WS_SSQ) + (size_t)(3 * L) * NTOK; const float* gmb = (const float*)(ws + WS_GMB) + (size_t)(3 * L) * NBATCH * DM;
    const float* bias = (const float*)(ws + WS_BIAS) + (size_t)(3 * L) * (MiB / 4);
    { pg8::EpiSwiglu E{HB, ssq, bias}; pg8::gemm_phase<NTOK, NGU, DM>(lds, XN, (const bf16_t*)(wk + WK1_GU1), G, bid, E); }
    xcd_barrier(bar);
    { pg8::EpiResid<L == 0, false> E{(L == 0) ? (const void*)a.in[0] : (const void*)XB, XB, ada + 2 * DM, ssq + NTOK, gmb + NBATCH * DM, XN, 0.5f, 0}; pg8::gemm_phase<NTOK, DM, FF>(lds, HB, (const bf16_t*)(wo + WO_D1), G, bid, E); }
    xcd_barrier(bar);
    { pg8::EpiProj E{HB, ssq + NTOK, bias + MiB / 4}; pg8::gemm_phase<NTOK, NIN, DM>(lds, XN, (const bf16_t*)(wk + WK1_IN), G, bid, E); }
    xcd_barrier(bar);
    mixer_phase(lds, HB, YB, (const bf16_t*)(ws + WS_WSGU) + (size_t)L * 8 * 128 * 128, a.in[12] + L * 8 * 128, a.in[9] + L * 64, a.in[10] + L * 64,
                a.in[13] + L * 3 * 512, a.in[14] + L * DM, G, bid, wid, lane);
    xcd_barrier(bar);
    { pg8::EpiResid<false, false> E{XB, XB, ada + 5 * DM, ssq + 2 * NTOK, gmb + 2 * NBATCH * DM, XN, 1.0f, 0}; pg8::gemm_phase<NTOK, DM, DM>(lds, YB, (const bf16_t*)(wo + WO_OUT), G, bid, E); }
    xcd_barrier(bar);
    { pg8::EpiSwiglu E{HB, ssq + 2 * NTOK, bias + 2 * (MiB / 4)}; pg8::gemm_phase<NTOK, NGU, DM>(lds, XN, (const bf16_t*)(wk + WK1_GU2), G, bid, E); }
    xcd_barrier(bar);
    { pg8::EpiResid<false, (L + 1 == NLAYER)> E{XB, (L + 1 == NLAYER) ? (void*)out : (void*)XB, ada + 8 * DM, ssq + 3 * NTOK, (L + 1 < NLAYER) ? gmb + 3 * NBATCH * DM : nullptr, XN, 0.5f, 0}; pg8::gemm_phase<NTOK, DM, FF>(lds, HB, (const bf16_t*)(wo + WO_D2), G, bid, E); }
    xcd_barrier(bar);
}

__global__ void __launch_bounds__(NTHREADS, 2) fwd_megakernel(Args a) {
    extern __shared__ __attribute__((aligned(16))) unsigned char lds_raw[];
    LAS unsigned char* lds = (LAS unsigned char*)lds_raw;
    cg::grid_group grid = cg::this_grid();
    const int tid = threadIdx.x, lane = tid & 63, wid = __builtin_amdgcn_readfirstlane(tid >> 6);
    const int G = gridDim.x, bid = blockIdx.x;
    const int gw = bid * NWAVES + wid, NGW = G * NWAVES;
    unsigned char* ws = a.ws;

    unsigned* barw = (unsigned*)(ws + WS_BAR);
    if (bid == 0) for (int i = tid; i < XCD_BAR_WORDS; i += NTHREADS) barw[i] = 0u;
    volatile LAS unsigned* bst = (volatile LAS unsigned*)(lds + STAGE_BYTES + 8192);
    if (tid == 0) { bst[0] = 0u; bst[1] = 0u; }
    prologue(lds, a, G, bid, tid, wid, lane);
    grid.sync();
    const XcdBarrier bar = xcd_barrier_post(barw, bst);

    {
        const float* ada0 = (const float*)(ws + WS_ADA); float* GMB = (float*)(ws + WS_GMB);
        for (int i = bid * NTHREADS + tid; i < 6 * NBATCH * DM; i += G * NTHREADS) {
            const int c = i & (DM - 1), b = (i >> 10) & 31, j = i >> 15, l = j / 3, sub = j % 3;
            const float* gsrc = (sub == 0 ? a.in[4] : (sub == 1 ? a.in[7] : a.in[16])) + l * DM;
            const float* ad = ada0 + (size_t)(l * NBATCH + b) * NADA + 3 * sub * DM;
            GMB[i] = gsrc[c] * (1.0f + ad[DM + c]);
            ((bf16_t*)(ws + WS_SHM))[i] = (bf16_t)(cvt_pk_bf16(ad[c], 0.f) & 0xffffu);
        }
        for (int i = bid * NTHREADS + tid; i < 64 * DM / 2; i += G * NTHREADS) ((unsigned*)(ws + WS_SHM))[192 * DM / 2 + i] = 0u;
        norm0_phase(a.in[0], (bf16_t*)(ws + WS_XN), (float*)(ws + WS_SSQ), a.in[4], ada0 + 1 * DM, gw, NGW, lane);
    }
    xcd_barrier(bar);
    { pg8::EpiBias E{(float*)(ws + WS_BIAS)}; pg8::gemm_phase<256, 2 * (2 * NGU + NIN), DM>(lds, (const bf16_t*)(ws + WS_SHM), (const bf16_t*)(ws + WS_WK1), G, bid, E); }
    xcd_barrier(bar);
    layer<0>(lds, a, bar, G, bid, wid, lane);
    layer<1>(lds, a, bar, G, bid, wid, lane);
    final_norm_phase(a.out, (const float*)(ws + WS_SSQ) + (size_t)6 * NTOK, a.in[19], gw, NGW, lane);
}

extern "C" void kernel_launch(void* const* d_in, const int* in_sizes, int n_in, void* d_out, int out_size, void* d_ws, size_t ws_size, hipStream_t stream) {
    static int grid = 0;
    if (grid == 0) {
        if (n_in != 20 || in_sizes[0] != NTOK * DM || out_size != NTOK * DM || ws_size < WS_END) {
            fprintf(stderr, "kernel_launch: unexpected shapes (n_in %d, in0 %d, out %d, ws %zu)\n", n_in, n_in > 0 ? in_sizes[0] : -1, out_size, ws_size); grid = -1; return; }
        int dev = 0, cus = 0, per_cu = 0;
        hipGetDevice(&dev);
        hipDeviceGetAttribute(&cus, hipDeviceAttributeMultiprocessorCount, dev);
        if (hipFuncSetAttribute((const void*)fwd_megakernel, hipFuncAttributeMaxDynamicSharedMemorySize, LDS_BYTES) != hipSuccess) { fprintf(stderr, "kernel_launch: hipFuncSetAttribute failed\n"); grid = -1; return; }
        if (hipOccupancyMaxActiveBlocksPerMultiprocessor(&per_cu, (const void*)fwd_megakernel, NTHREADS, LDS_BYTES) != hipSuccess || per_cu < 1) { fprintf(stderr, "kernel_launch: occupancy query says %d\n", per_cu); per_cu = 1; }
        (void)hipGetLastError();
        grid = cus;
    }
    if (grid < 0) return;
    Args a{};
    for (int i = 0; i < 20; ++i) a.in[i] = (const float*)d_in[i];
    a.out = (float*)d_out; a.ws = (unsigned char*)d_ws;
    void* args[] = {&a};
    hipError_t e = hipLaunchCooperativeKernel((const void*)fwd_megakernel, dim3(grid), dim3(NTHREADS), args, LDS_BYTES, stream);
    if (e != hipSuccess) fprintf(stderr, "kernel_launch: cooperative launch failed: %s (grid %d)\n", hipGetErrorString(e), grid);
}
```

```cpp
#include <hip/hip_runtime.h>
#include <hip/hip_cooperative_groups.h>
#include <cstdio>
#include <cstdint>
namespace cg = cooperative_groups;

#define LAS __attribute__((address_space(3)))
typedef unsigned short bf16_t;
typedef short bf16x8 __attribute__((ext_vector_type(8)));
typedef float f32x4 __attribute__((ext_vector_type(4)));
typedef float f32x2 __attribute__((ext_vector_type(2)));
typedef unsigned u32x4 __attribute__((ext_vector_type(4)));
typedef unsigned u32x2 __attribute__((ext_vector_type(2)));

constexpr int NTOK = 65536, DM = 1024, FF = 2816, NGU = 2 * FF, NIN = 2560, NPJ = 2048, NLAYER = 2, SEQ = 2048, NBATCH = 32, NADA = 9 * DM;
constexpr float EPS = 1e-6f;
constexpr int NTHREADS = 512, NWAVES = 8;
constexpr int STAGE_BYTES = 131072;
constexpr int LDS_BYTES = STAGE_BYTES + 8192 + 64;

constexpr size_t MiB = 1048576;
constexpr size_t WS_ADA = 0;
constexpr size_t WS_WSGU = 0x240000;
constexpr size_t WS_BAR = 0x2C0000;
constexpr size_t WS_SSQ = 3 * MiB;
constexpr size_t WS_GMB = 5 * MiB;
constexpr size_t WS_SHM = 6 * MiB;
constexpr size_t WS_BIAS = 7 * MiB;
constexpr size_t WS_WK1 = 16 * MiB;
constexpr size_t WK1_STRIDE = 27 * MiB, WK1_GU1 = 0, WK1_IN = 11 * MiB, WK1_GU2 = 16 * MiB;
constexpr size_t WS_WOTH = 70 * MiB;
constexpr size_t WOTH_STRIDE = 13 * MiB, WO_D1 = 0, WO_OUT = 5 * MiB + MiB / 2, WO_D2 = 7 * MiB + MiB / 2;
constexpr size_t WS_XN = 96 * MiB;
constexpr size_t WS_YB = 224 * MiB;
constexpr size_t WS_HB = 352 * MiB;
constexpr size_t WS_XB = 704 * MiB;
constexpr size_t WS_END = 832 * MiB;

__device__ __forceinline__ unsigned cvt_pk_bf16(float lo, float hi) { unsigned r; asm("v_cvt_pk_bf16_f32 %0, %1, %2" : "=v"(r) : "v"(lo), "v"(hi)); return r; }
__device__ __forceinline__ float bf_lo(unsigned w) { return __uint_as_float(w << 16); }
__device__ __forceinline__ float bf_hi(unsigned w) { return __uint_as_float(w & 0xffff0000u); }
template <int CTRL> __device__ __forceinline__ float dpp_get(float v) { return __builtin_bit_cast(float, __builtin_amdgcn_update_dpp(0, __builtin_bit_cast(int, v), CTRL, 0xf, 0xf, true)); }
__device__ __forceinline__ float sum_lanes8(float v) {
    v += dpp_get<0xB1>(v);
    v += dpp_get<0x4E>(v);
    v += dpp_get<0x141>(v);
    return v;
}
__device__ __forceinline__ float sum_rows(float v) {
    const unsigned x = __builtin_bit_cast(unsigned, v);
    const auto a = __builtin_amdgcn_permlane16_swap(x, x, false, false);
    const unsigned a0 = a[0], a1 = a[1];
    v = __builtin_bit_cast(float, a0) + __builtin_bit_cast(float, a1);
    const unsigned y = __builtin_bit_cast(unsigned, v);
    const auto b = __builtin_amdgcn_permlane32_swap(y, y, false, false);
    const unsigned b0 = b[0], b1 = b[1];
    return __builtin_bit_cast(float, b0) + __builtin_bit_cast(float, b1);
}
__device__ __forceinline__ float wave_sum(float v) { v = sum_lanes8(v); v += dpp_get<0x140>(v);   return sum_rows(v); }
__device__ __forceinline__ f32x2 gelu_pk(f32x2 v) {
    const f32x2 av = __builtin_elementwise_abs(v), d = av * 0.2316418882f + 1.0f;
    f32x2 t; t.x = __builtin_amdgcn_rcpf(d.x); t.y = __builtin_amdgcn_rcpf(d.y);
    f32x2 q = t * 0.5307027145f + (-0.7265760135f); q = q * t + 0.7107068705f; q = q * t + (-0.142248368f); q = q * t + 0.127414796f; q = q * t;
    const f32x2 s = (v * v) * (-0.72134752044f);
    f32x2 e; e.x = __builtin_amdgcn_exp2f(s.x); e.y = __builtin_amdgcn_exp2f(s.y);
    const f32x2 m = v * (q * e), r = v - m;
    f32x2 o; o.x = v.x < 0.f ? m.x : r.x; o.y = v.y < 0.f ? m.y : r.y; return o;
}
__device__ __forceinline__ f32x2 swiglu_pk(f32x2 g, f32x2 u) {
    const f32x2 t = g * (-1.44269504089f); f32x2 e; e.x = __builtin_amdgcn_exp2f(t.x); e.y = __builtin_amdgcn_exp2f(t.y);
    const f32x2 d = e + 1.0f; f32x2 r; r.x = __builtin_amdgcn_rcpf(d.x); r.y = __builtin_amdgcn_rcpf(d.y);
    return (g * r) * u;
}
__device__ __forceinline__ float silu_f(float g) { return g * __builtin_amdgcn_rcpf(1.0f + __builtin_amdgcn_exp2f(-1.44269504089f * g)); }

namespace pg8 {
constexpr int BM = 256, BK = 64, HALF = 128, HTB = HALF * BK * 2, NXCD = 8, WGM = 8;
__host__ __device__ __forceinline__ int lds_byte(int r, int c) { const int st = (r >> 4) * 2 + (c >> 5), rr = r & 15, cc = c & 31, ob = rr * 64 + cc * 2; return st * 1024 + (ob ^ (((ob >> 9) & 1) << 5)); }
__host__ __device__ __forceinline__ void stage_rc(int b, int& R, int& C) { const int st = b / 1024, sb = b % 1024, swz = sb ^ (((sb >> 9) & 1) << 5); R = (st >> 1) * 16 + swz / 64; C = (st & 1) * 32 + (swz % 64) / 2; }
__host__ __device__ __forceinline__ int perm32(int rho) { const int n = rho >> 4, i = rho & 15; return 8 * (i >> 2) + 4 * n + (i & 3); }

struct Unit { int pm, pn; };
template <int M, int N> struct StaticOrder {
    static constexpr int nM = M / BM, nN = N / BM, nwg = nM * nN;
    int G, c;
    __device__ __forceinline__ void init(int G_, int c_) { G = G_; c = c_; }
    __device__ __forceinline__ bool next(int i, Unit& u) const {
        const long L = (long)i * G + c; if (L >= nwg) return false;
        int wgid = (int)L; { constexpr int q = nwg / NXCD, r = nwg % NXCD; const int xcd = wgid % NXCD, off = wgid / NXCD; wgid = (xcd < r ? xcd * (q + 1) : r * (q + 1) + (xcd - r) * q) + off; }
        constexpr int nig = WGM * nN; const int gid = wgid / nig, fm = gid * WGM, gsz = (nM - fm) < WGM ? (nM - fm) : WGM;
        u.pm = fm + ((wgid % nig) % gsz); u.pn = (wgid % nig) / gsz; return true;
    }
};

struct EpiSwiglu {
    static constexpr bool PERM = true;
    bf16_t* H; const float* ssq; const float* bias;
    __device__ __forceinline__ void operator()(const f32x4 (&acc)[2][2][4][2], const Unit& u, int wr, int wc, int fr, int fq) const {
        const int row0 = u.pm * BM + wr * 64 + fr, col0 = u.pn * HALF + wc * 32 + 8 * fq;
        const float* bp = bias + (size_t)(u.pm >> 3) * NGU + u.pn * BM + wc * 32 + 8 * fq;
        float rs[2][4];
#pragma unroll
        for (int ai = 0; ai < 2; ++ai)
#pragma unroll
            for (int m = 0; m < 4; ++m) rs[ai][m] = ssq[row0 + ai * HALF + m * 16];
        const f32x4 bg0 = *(const f32x4*)bp, bg1 = *(const f32x4*)(bp + 4), bu0 = *(const f32x4*)(bp + HALF), bu1 = *(const f32x4*)(bp + HALF + 4);
#pragma unroll
        for (int ai = 0; ai < 2; ++ai)
#pragma unroll
            for (int m = 0; m < 4; ++m) rs[ai][m] = __builtin_amdgcn_rsqf(rs[ai][m] * (1.0f / DM) + EPS);
#pragma unroll
        for (int ai = 0; ai < 2; ++ai)
#pragma unroll
            for (int m = 0; m < 4; ++m) {
                const int row = row0 + ai * HALF + m * 16;
                const float rstd = rs[ai][m];
                bf16_t* rowp = H + (size_t)row * FF + col0;
                const f32x4 g0 = acc[ai][0][m][0] * rstd + bg0, g1 = acc[ai][0][m][1] * rstd + bg1, u0 = acc[ai][1][m][0] * rstd + bu0, u1 = acc[ai][1][m][1] * rstd + bu1;
                const f32x2 h0 = swiglu_pk((f32x2){g0[0], g0[1]}, (f32x2){u0[0], u0[1]}), h1 = swiglu_pk((f32x2){g0[2], g0[3]}, (f32x2){u0[2], u0[3]});
                const f32x2 h2 = swiglu_pk((f32x2){g1[0], g1[1]}, (f32x2){u1[0], u1[1]}), h3 = swiglu_pk((f32x2){g1[2], g1[3]}, (f32x2){u1[2], u1[3]});
                u32x4 w; w.x = cvt_pk_bf16(h0.x, h0.y); w.y = cvt_pk_bf16(h1.x, h1.y); w.z = cvt_pk_bf16(h2.x, h2.y); w.w = cvt_pk_bf16(h3.x, h3.y);
                *(u32x4*)rowp = w;
            }
    }
};
struct EpiProj {
    static constexpr bool PERM = true;
    bf16_t* O; const float* ssq; const float* bias;
    __device__ __forceinline__ void operator()(const f32x4 (&acc)[2][2][4][2], const Unit& u, int wr, int wc, int fr, int fq) const {
        const int row0 = u.pm * BM + wr * 64 + fr, slot0 = u.pn * BM + wc * 32 + 8 * fq;
        const bool act = u.pn < 4, pair = u.pn >= 6;
        const int col0 = pair ? 1536 + (u.pn - 6) * HALF + wc * 32 + 8 * fq : slot0;
        const float* bp = bias + (size_t)(u.pm >> 3) * NIN + slot0;
        f32x4 bv[2][2];
#pragma unroll
        for (int bj = 0; bj < 2; ++bj)
#pragma unroll
            for (int n = 0; n < 2; ++n) bv[bj][n] = *(const f32x4*)(bp + bj * HALF + 4 * n);
        float rs[2][4];
#pragma unroll
        for (int ai = 0; ai < 2; ++ai)
#pragma unroll
            for (int m = 0; m < 4; ++m) rs[ai][m] = ssq[row0 + ai * HALF + m * 16];
#pragma unroll
        for (int ai = 0; ai < 2; ++ai)
#pragma unroll
            for (int m = 0; m < 4; ++m) rs[ai][m] = __builtin_amdgcn_rsqf(rs[ai][m] * (1.0f / DM) + EPS);
#pragma unroll
        for (int ai = 0; ai < 2; ++ai)
#pragma unroll
            for (int m = 0; m < 4; ++m) {
                const int row = row0 + ai * HALF + m * 16;
                const float rstd = rs[ai][m];
                bf16_t* rowp = O + (size_t)row * NPJ + col0;
                if (pair) {
                    const f32x4 z0 = (acc[ai][0][m][0] * rstd + bv[0][0]) * (acc[ai][1][m][0] * rstd + bv[1][0]), z1 = (acc[ai][0][m][1] * rstd + bv[0][1]) * (acc[ai][1][m][1] * rstd + bv[1][1]);
                    u32x4 w; w.x = cvt_pk_bf16(z0[0], z0[1]); w.y = cvt_pk_bf16(z0[2], z0[3]); w.z = cvt_pk_bf16(z1[0], z1[1]); w.w = cvt_pk_bf16(z1[2], z1[3]);
                    *(u32x4*)rowp = w;
                } else {
#pragma unroll
                    for (int bj = 0; bj < 2; ++bj) {
                        f32x4 v0 = acc[ai][bj][m][0] * rstd + bv[bj][0], v1 = acc[ai][bj][m][1] * rstd + bv[bj][1];
                        if (act) { f32x2 a = gelu_pk((f32x2){v0[0], v0[1]}), b = gelu_pk((f32x2){v0[2], v0[3]}), c = gelu_pk((f32x2){v1[0], v1[1]}), d = gelu_pk((f32x2){v1[2], v1[3]});
                            v0 = (f32x4){a.x, a.y, b.x, b.y}; v1 = (f32x4){c.x, c.y, d.x, d.y}; }
                        u32x4 w; w.x = cvt_pk_bf16(v0[0], v0[1]); w.y = cvt_pk_bf16(v0[2], v0[3]); w.z = cvt_pk_bf16(v1[0], v1[1]); w.w = cvt_pk_bf16(v1[2], v1[3]);
                        *(u32x4*)(rowp + bj * HALF) = w;
                    }
                }
            }
    }
};
template <bool XIN_F32, bool XOUT_F32> struct EpiResid {
    static constexpr bool PERM = true;
    const void* xin; void* xout; const float* gate; float* ssq_next; const float* gm_next; bf16_t* xn; float scale; int pad_;
    __device__ __forceinline__ void operator()(const f32x4 (&acc)[2][2][4][2], const Unit& u, int wr, int wc, int fr, int fq) const {
        const void* const xin = this->xin; void* const xout = this->xout; const float* const gate = this->gate; const float scale = this->scale;
        float* const ssq_next = this->ssq_next; const float* const gm_next = this->gm_next; bf16_t* const xn = this->xn;
        const unsigned voff = (unsigned)(fr * DM + 8 * fq);
        const size_t uoff = (size_t)(u.pm * BM + wr * 64) * DM + (size_t)(u.pn * BM + wc * 32);
        const int b = u.pm >> 3, colq = u.pn * BM + wc * 32 + 8 * fq;
#pragma unroll
        for (int bj = 0; bj < 2; ++bj) {
            float ss[2][4];
#pragma unroll
            for (int ai = 0; ai < 2; ++ai)
#pragma unroll
                for (int m = 0; m < 4; ++m) ss[ai][m] = 0.f;
            u32x4 xb[2][4];
            if (!XIN_F32) {
#pragma unroll
                for (int ai = 0; ai < 2; ++ai)
#pragma unroll
                    for (int m = 0; m < 4; ++m) xb[ai][m] = *(const u32x4*)((const bf16_t*)xin + uoff + (size_t)((ai * HALF + m * 16) * DM + bj * HALF) + voff);
            }
            f32x4 gv[2], gm[2];
#pragma unroll
            for (int n = 0; n < 2; ++n) { gv[n] = *(const f32x4*)(gate + (size_t)b * NADA + colq + bj * HALF + 4 * n) * scale;
                gm[n] = gm_next ? *(const f32x4*)(gm_next + (size_t)b * DM + colq + bj * HALF + 4 * n) : (f32x4){0.f, 0.f, 0.f, 0.f}; }
#pragma unroll
            for (int ai = 0; ai < 2; ++ai) {
                f32x4 xv[4][2];
                if (XIN_F32) {
#pragma unroll
                    for (int m = 0; m < 4; ++m)
#pragma unroll
                        for (int n = 0; n < 2; ++n) xv[m][n] = *(const f32x4*)((const float*)xin + uoff + (size_t)((ai * HALF + m * 16) * DM + bj * HALF + 4 * n) + voff);
                }
#pragma unroll
                for (int m = 0; m < 4; ++m) {
                    const size_t eo = uoff + (size_t)((ai * HALF + m * 16) * DM + bj * HALF) + voff;
                    f32x4 x0, x1;
                    if (XIN_F32) { x0 = xv[m][0]; x1 = xv[m][1]; }
                    else { const u32x4 w = xb[ai][m]; x0 = (f32x4){bf_lo(w.x), bf_hi(w.x), bf_lo(w.y), bf_hi(w.y)}; x1 = (f32x4){bf_lo(w.z), bf_hi(w.z), bf_lo(w.w), bf_hi(w.w)}; }
                    const f32x4 y0 = x0 + gv[0] * acc[ai][bj][m][0], y1 = x1 + gv[1] * acc[ai][bj][m][1];
                    if (XOUT_F32) { *(f32x4*)((float*)xout + eo) = y0; *(f32x4*)((float*)xout + eo + 4) = y1; }
                    else { u32x4 w; w.x = cvt_pk_bf16(y0[0], y0[1]); w.y = cvt_pk_bf16(y0[2], y0[3]); w.z = cvt_pk_bf16(y1[0], y1[1]); w.w = cvt_pk_bf16(y1[2], y1[3]); *(u32x4*)((bf16_t*)xout + eo) = w; }
                    ss[ai][m] += (y0[0] * y0[0] + y0[1] * y0[1]) + (y0[2] * y0[2] + y0[3] * y0[3]) + (y1[0] * y1[0] + y1[1] * y1[1]) + (y1[2] * y1[2] + y1[3] * y1[3]);
                    if (gm_next) { const f32x4 z0 = y0 * gm[0], z1 = y1 * gm[1]; u32x4 w; w.x = cvt_pk_bf16(z0[0], z0[1]); w.y = cvt_pk_bf16(z0[2], z0[3]); w.z = cvt_pk_bf16(z1[0], z1[1]); w.w = cvt_pk_bf16(z1[2], z1[3]);
                        *(u32x4*)(xn + eo) = w; }
                }
                if (XIN_F32) asm volatile("" ::: "memory");
            }
#pragma unroll
            for (int ai = 0; ai < 2; ++ai)
#pragma unroll
                for (int m = 0; m < 4; ++m) { float s = ss[ai][m]; s = sum_rows(s);
                    if (fq == 0) atomicAdd(ssq_next + (u.pm * BM + wr * 64 + ai * HALF + m * 16 + fr), s); }
            asm volatile("" ::: "memory");
        }
    }
};
struct EpiBias {
    static constexpr bool PERM = true;
    float* bias0;
    __device__ __forceinline__ void operator()(const f32x4 (&acc)[2][2][4][2], const Unit& u, int wr, int wc, int fr, int fq) const {
        const int l = u.pn / 54, q = u.pn % 54, sub = q < 22 ? 0 : (q < 32 ? 1 : 2), pnl = q - (sub == 0 ? 0 : (sub == 1 ? 22 : 32)), j = 3 * l + sub, Nj = (sub == 1) ? NIN : NGU;
        float* bp = bias0 + (size_t)j * (MiB / 4) + pnl * BM + wc * 32 + 8 * fq;
#pragma unroll
        for (int ai = 0; ai < 2; ++ai)
#pragma unroll
            for (int m = 0; m < 4; ++m)
                if (4 * ai + 2 * wr + (m >> 1) == j) {
                    float* rp = bp + (size_t)(16 * (m & 1) + fr) * Nj;
#pragma unroll
                    for (int bj = 0; bj < 2; ++bj)
#pragma unroll
                        for (int n = 0; n < 2; ++n) *(f32x4*)(rp + bj * HALF + 4 * n) = acc[ai][bj][m][n];
                }
    }
};

template <int M, int N, int K, class Epi>
__device__ __forceinline__ void gemm_phase(LAS unsigned char* lds, const bf16_t* gA, const bf16_t* gBt, int G, int c, const Epi E) {
    StaticOrder<M, N> S; S.init(G, c);
    int tid = threadIdx.x; asm volatile("" : "+v"(tid));
    const int wid = __builtin_amdgcn_readfirstlane(tid >> 6), lane = tid & 63, wr = wid >> 2, wc = wid & 3, fr = lane & 15, fq = lane >> 4;
    constexpr int nt = K / BK;
    unsigned voffA[2], voffB[2];
#pragma unroll
    for (int i = 0; i < 2; ++i) { int R, C; stage_rc(tid * 16 + i * 8192, R, C); const int Rb = Epi::PERM ? ((R & ~31) + perm32(R & 31)) : R;
        voffA[i] = (unsigned)(R * K + C) * 2u; voffB[i] = (unsigned)(Rb * K + C) * 2u; }
    constexpr size_t kstep = (size_t)(BK * 2);
    constexpr size_t hstep = (size_t)HALF * K * 2;
    constexpr size_t tstep = 2 * hstep;
    const unsigned ldsw = (unsigned)wid * 1024u;
    const int aoff = lds_byte(wr * 64 + fr, fq * 8), boff = lds_byte(wc * 32 + fr, fq * 8);
#define PG8_SA(b, h) (((b) * 2 + (h)) * HTB)
#define PG8_SB(b, h) ((4 + (b) * 2 + (h)) * HTB)
#define PG8_STAGE(bufoff, gbase, voff) do { _Pragma("unroll") for (int _i = 0; _i < 2; ++_i) \
        __builtin_amdgcn_global_load_lds((const unsigned*)((const char*)(gbase) + (voff)[_i]), (LAS unsigned*)(lds + (bufoff) + ldsw + _i * 8192), 16, 0, 0); } while (0)
#define PG8_LDA(dst, b, h) do { _Pragma("unroll") for (int m = 0; m < 4; ++m) _Pragma("unroll") for (int k = 0; k < 2; ++k) dst[m][k] = *(const LAS bf16x8*)(lds + PG8_SA(b, h) + aoff + m * 2048 + k * 1024); } while (0)
#define PG8_LDB(dst, b, h) do { _Pragma("unroll") for (int n = 0; n < 2; ++n) _Pragma("unroll") for (int k = 0; k < 2; ++k) dst[n][k] = *(const LAS bf16x8*)(lds + PG8_SB(b, h) + boff + n * 2048 + k * 1024); } while (0)
#define PG8_MMA(ai, bj, At, Bt) do { __builtin_amdgcn_s_setprio(1); _Pragma("unroll") for (int m = 0; m < 4; ++m) _Pragma("unroll") for (int n = 0; n < 2; ++n) _Pragma("unroll") for (int k = 0; k < 2; ++k) \
        acc[ai][bj][m][n] = __builtin_amdgcn_mfma_f32_16x16x32_bf16(Bt[n][k], At[m][k], acc[ai][bj][m][n], 0, 0, 0); __builtin_amdgcn_s_setprio(0); } while (0)
#define PG8_WAIT_V(n) asm volatile("s_waitcnt vmcnt(" #n ")" ::: "memory")
#define PG8_WAIT_L(n) asm volatile("s_waitcnt lgkmcnt(" #n ")" ::: "memory")
#define PG8_BAR __builtin_amdgcn_s_barrier()
#define PG8_SCHED __builtin_amdgcn_sched_barrier(0)
    Unit cur, nxt; int ui = 0;
    if (!S.next(0, cur)) return;
    f32x4 acc[2][2][4][2];
#pragma unroll
    for (int a = 0; a < 2; ++a)
#pragma unroll
        for (int b = 0; b < 2; ++b)
#pragma unroll
            for (int m = 0; m < 4; ++m)
#pragma unroll
                for (int n = 0; n < 2; ++n) acc[a][b][m][n] = (f32x4){0.f, 0.f, 0.f, 0.f};
    bf16x8 At[4][2], B0[2][2], B1[2][2];
    const char* cA = (const char*)gA + (size_t)cur.pm * tstep; const char* cB = (const char*)gBt + (size_t)cur.pn * tstep;
    PG8_STAGE(PG8_SB(0, 0), cB, voffB); PG8_STAGE(PG8_SB(0, 1), cB + hstep, voffB); PG8_STAGE(PG8_SA(0, 0), cA, voffA); PG8_STAGE(PG8_SA(0, 1), cA + hstep, voffA);
    if (wr == 1) PG8_BAR;
    PG8_WAIT_V(2); PG8_BAR;
    PG8_STAGE(PG8_SB(1, 0), cB + kstep, voffB); PG8_STAGE(PG8_SA(1, 0), cA + kstep, voffA); PG8_STAGE(PG8_SB(1, 1), cB + hstep + kstep, voffB);
    PG8_WAIT_V(6); PG8_BAR;
    for (;;) {
        const bool has_next = S.next(ui + 1, nxt);
        const char* nA = has_next ? (const char*)gA + (size_t)nxt.pm * tstep : cA; const char* nB = has_next ? (const char*)gBt + (size_t)nxt.pn * tstep : cB;
        for (int t = 0; t < nt; t += 2) {
            const bool last = (t == nt - 2);
            const char* a1 = cA + (size_t)(t + 1) * kstep;
            const char* a2 = last ? nA : cA + (size_t)(t + 2) * kstep; const char* b2 = last ? nB : cB + (size_t)(t + 2) * kstep;
            const char* a3 = a2 + kstep; const char* b3 = b2 + kstep;
            PG8_LDB(B0, 0, 0); PG8_LDB(B1, 0, 1); PG8_SCHED; PG8_LDA(At, 0, 0); PG8_STAGE(PG8_SA(1, 1), a1 + hstep, voffA);
            PG8_WAIT_V(8); PG8_WAIT_L(0); PG8_BAR; PG8_MMA(0, 0, At, B0); PG8_MMA(0, 1, At, B1); PG8_BAR; PG8_SCHED;
            PG8_LDA(At, 0, 1); PG8_STAGE(PG8_SB(0, 0), b2, voffB); PG8_STAGE(PG8_SB(0, 1), b2 + hstep, voffB); PG8_STAGE(PG8_SA(0, 0), a2, voffA);
            PG8_WAIT_V(8); PG8_WAIT_L(0); PG8_BAR; PG8_MMA(1, 0, At, B0); PG8_MMA(1, 1, At, B1); PG8_BAR; PG8_SCHED;
            PG8_LDB(B0, 1, 0); PG8_LDB(B1, 1, 1); PG8_SCHED; PG8_LDA(At, 1, 0); PG8_STAGE(PG8_SA(0, 1), a2 + hstep, voffA);
            PG8_WAIT_V(8); PG8_WAIT_L(0); PG8_BAR; PG8_MMA(0, 0, At, B0); PG8_MMA(0, 1, At, B1); PG8_BAR; PG8_SCHED;
            PG8_LDA(At, 1, 1); PG8_STAGE(PG8_SB(1, 0), b3, voffB); PG8_STAGE(PG8_SB(1, 1), b3 + hstep, voffB); PG8_STAGE(PG8_SA(1, 0), a3, voffA);
            PG8_WAIT_V(8); PG8_WAIT_L(0); PG8_BAR; PG8_MMA(1, 0, At, B0); PG8_MMA(1, 1, At, B1); PG8_BAR; PG8_SCHED;
        }
        if (wr == 0) PG8_BAR;
        E(acc, cur, wr, wc, fr, fq);
        if (!has_next) break;
#pragma unroll
        for (int a = 0; a < 2; ++a)
#pragma unroll
            for (int b = 0; b < 2; ++b)
#pragma unroll
                for (int m = 0; m < 4; ++m)
#pragma unroll
                    for (int n = 0; n < 2; ++n) acc[a][b][m][n] = (f32x4){0.f, 0.f, 0.f, 0.f};
        cur = nxt; cA = nA; cB = nB; ++ui;
        if (wr == 1) PG8_BAR;
    }
    PG8_WAIT_V(0);
    PG8_BAR;
#undef PG8_SA
#undef PG8_SB
#undef PG8_STAGE
#undef PG8_LDA
#undef PG8_LDB
#undef PG8_MMA
#undef PG8_WAIT_V
#undef PG8_WAIT_L
#undef PG8_BAR
#undef PG8_SCHED
}
}

#define XB_TMO      128
#define XB_XCNT(j)  (256  + 64 * (j))
#define XB_XSUB(j)  (1280 + 64 * (j))
#define XB_XGEN(j)  (2304 + 64 * (j))
#define XB_TOP      3328
#define XB_TOPGEN   3392
#define XCD_BAR_WORDS 3456
#define XB_SPIN_CAP (1u << 20)
__device__ __forceinline__ unsigned xb_ld(unsigned* p)              { return __hip_atomic_load(p, __ATOMIC_RELAXED, __HIP_MEMORY_SCOPE_AGENT); }
__device__ __forceinline__ unsigned xb_add(unsigned* p, unsigned v) { return __hip_atomic_fetch_add(p, v, __ATOMIC_RELAXED, __HIP_MEMORY_SCOPE_AGENT); }
__device__ __forceinline__ unsigned xb_xcc_id() { return (unsigned)__builtin_amdgcn_s_getreg((3 << 11) | 20) & 0xFu; }
#define XB_SPIN(cond, bar) do { unsigned _sp = 0; while (cond) { __builtin_amdgcn_s_sleep(1); \
    if ((++_sp & 255u) == 0u) { if (xb_ld(&(bar)[XB_TMO])) break; if (_sp > XB_SPIN_CAP) { atomicAdd(&(bar)[XB_TMO], 1u); break; } } } } while (0)
struct XcdBarrier { unsigned* bar; unsigned x; volatile LAS unsigned* st; };
__device__ __forceinline__ XcdBarrier xcd_barrier_post(unsigned* bar, volatile LAS unsigned* st) {
    XcdBarrier b; b.bar = bar; b.x = xb_xcc_id(); b.st = st;
    if (threadIdx.x == 0) (void)xb_add(&bar[XB_XCNT(b.x)], 1u);
    return b;
}
__device__ __forceinline__ void xcd_barrier_complete(unsigned* bar, unsigned x, unsigned& nloc, unsigned& nx) {
    const unsigned G = gridDim.x * gridDim.y * gridDim.z;
    unsigned sum, cnt, mine, sp = 0u;
    for (;;) {
        sum = 0u; cnt = 0u; mine = 0u;
#pragma unroll
        for (unsigned j = 0; j < 16; ++j) { const unsigned c = xb_ld(&bar[XB_XCNT(j)]); sum += c; cnt += (c > 0u) ? 1u : 0u; mine = (j == x) ? c : mine; }
        if (sum == G) break;
        __builtin_amdgcn_s_sleep(1);
        if ((++sp & 255u) == 0u) { if (xb_ld(&bar[XB_TMO])) break; if (sp > XB_SPIN_CAP) { atomicAdd(&bar[XB_TMO], 1u); break; } }
    }
    nloc = mine > 0u ? mine : 1u; nx = cnt > 0u ? cnt : 1u;
}
__device__ __forceinline__ void xcd_barrier(const XcdBarrier& b) {
    asm volatile("s_waitcnt vmcnt(0)" ::: "memory");
    __syncthreads();
    if (threadIdx.x == 0) {
        unsigned* bar = b.bar;
        __builtin_amdgcn_s_waitcnt(0);
        unsigned nloc = b.st[0], nx = b.st[1];
        if (nloc == 0u) { xcd_barrier_complete(bar, b.x, nloc, nx); b.st[0] = nloc; b.st[1] = nx; }
        const unsigned old = xb_add(&bar[XB_XSUB(b.x)], 1u);
        const unsigned gen = old / nloc;
        if (old + 1u == (gen + 1u) * nloc) {
            __builtin_amdgcn_fence(__ATOMIC_RELEASE, "agent");
            asm volatile("s_waitcnt vmcnt(0)" ::: "memory");
            const unsigned og = xb_add(&bar[XB_TOP], 1u);
            const unsigned tg = og / nx;
            if (og + 1u == (tg + 1u) * nx) xb_add(&bar[XB_TOPGEN], 1u);
            else XB_SPIN(xb_ld(&bar[XB_TOPGEN]) == tg, bar);
            __builtin_amdgcn_fence(__ATOMIC_ACQUIRE, "agent");
            xb_add(&bar[XB_XGEN(b.x)], 1u);
            asm volatile("s_waitcnt vmcnt(0)" ::: "memory");
        } else {
            XB_SPIN(xb_ld(&bar[XB_XGEN(b.x)]) == gen, bar);
            __builtin_amdgcn_fence(__ATOMIC_ACQUIRE, "agent");
            asm volatile("s_waitcnt vmcnt(0)" ::: "memory");
        }
    }
    __syncthreads();
}

template <int MODE>
__device__ __forceinline__ void transpose_item(const float* W, int K, int N, bf16_t* WT, LAS float* scr, int item, int lane) {
    const int nblk = N / 32, kb = item / nblk, nb = item % nblk, k0 = 64 * kb, n0 = 32 * nb;
    int nrow = n0;
    if (MODE == 1) { const int nn = (n0 < FF) ? n0 : n0 - FF; nrow = ((nn >> 7) << 8) + (nn & 127) + ((n0 < FF) ? 0 : 128); }
    if (MODE == 2 && n0 >= 1536) { const int nn = (n0 < 2048) ? n0 - 1536 : n0 - 2048; nrow = 1536 + ((nn >> 7) << 8) + (nn & 127) + ((n0 < 2048) ? 0 : 128); }
    { float tv[32]; const float* wp = W + (size_t)(k0 + (lane >> 5)) * N + n0 + (lane & 31);
#pragma unroll
      for (int i = 0; i < 32; ++i) tv[i] = wp[(size_t)(2 * i) * N];
#pragma unroll
      for (int i = 0; i < 32; ++i) scr[(2 * i + (lane >> 5)) * 33 + (lane & 31)] = tv[i]; }
    asm volatile("s_waitcnt lgkmcnt(0)" ::: "memory");
    const int c = lane & 7;
#pragma unroll
    for (int j = 0; j < 4; ++j) { const int n = (lane >> 3) + 8 * j; const LAS float* s = scr + (8 * c) * 33 + n;
        u32x4 o; o.x = cvt_pk_bf16(s[0 * 33], s[1 * 33]); o.y = cvt_pk_bf16(s[2 * 33], s[3 * 33]); o.z = cvt_pk_bf16(s[4 * 33], s[5 * 33]); o.w = cvt_pk_bf16(s[6 * 33], s[7 * 33]);
        *(u32x4*)(WT + (size_t)(nrow + n) * K + k0 + 8 * c) = o; }
    asm volatile("s_waitcnt lgkmcnt(0)" ::: "memory");
}

struct Args { const float* in[20]; float* out; unsigned char* ws; };

__device__ __forceinline__ void prologue(LAS unsigned char* lds, const Args& a, int G, int bid, int tid, int wid, int lane) {
    unsigned char* ws = a.ws;
    LAS float* scr = (LAS float*)(lds + wid * 16384);
    const int gw = bid * NWAVES + wid, NGW = G * NWAVES;
    constexpr int I_GU = (DM / 64) * (NGU / 32), I_D = (FF / 64) * (DM / 32), I_IN = (DM / 64) * (NIN / 32), I_OUT = (DM / 64) * (DM / 32);
    constexpr int I_LAYER = 2 * I_GU + 2 * I_D + I_IN + I_OUT;
    for (int it = gw; it < NLAYER * I_LAYER; it += NGW) {
        const int l = it / I_LAYER; int r = it % I_LAYER;
        unsigned char* wk = ws + WS_WK1 + (size_t)l * WK1_STRIDE; unsigned char* wo = ws + WS_WOTH + (size_t)l * WOTH_STRIDE;
        if (r < I_GU) { transpose_item<1>(a.in[5] + (size_t)l * DM * NGU, DM, NGU, (bf16_t*)(wk + WK1_GU1), scr, r, lane); continue; } r -= I_GU;
        if (r < I_GU) { transpose_item<1>(a.in[17] + (size_t)l * DM * NGU, DM, NGU, (bf16_t*)(wk + WK1_GU2), scr, r, lane); continue; } r -= I_GU;
        if (r < I_D) { transpose_item<0>(a.in[6] + (size_t)l * FF * DM, FF, DM, (bf16_t*)(wo + WO_D1), scr, r, lane); continue; } r -= I_D;
        if (r < I_D) { transpose_item<0>(a.in[18] + (size_t)l * FF * DM, FF, DM, (bf16_t*)(wo + WO_D2), scr, r, lane); continue; } r -= I_D;
        if (r < I_IN) { transpose_item<2>(a.in[8] + (size_t)l * DM * NIN, DM, NIN, (bf16_t*)(wk + WK1_IN), scr, r, lane); continue; } r -= I_IN;
        transpose_item<0>(a.in[15] + (size_t)l * DM * DM, DM, DM, (bf16_t*)(wo + WO_OUT), scr, r, lane);
    }
    { f32x4* z = (f32x4*)(ws + WS_SSQ) + NTOK / 4; for (int i = bid * NTHREADS + tid; i < 6 * NTOK / 4; i += G * NTHREADS) z[i] = (f32x4){0.f, 0.f, 0.f, 0.f}; }
    {
        const float* wsrc = a.in[11]; bf16_t* wdst = (bf16_t*)(ws + WS_WSGU);
        for (int i = bid * NTHREADS + tid; i < NLAYER * 8 * 128 * 128 / 2; i += G * NTHREADS) {
            const int e = 2 * i, s = e & 127, t = (e >> 7) & 127;
            const f32x2 v = *(const f32x2*)(wsrc + e);
            ((unsigned*)wdst)[i] = cvt_pk_bf16(s <= t ? v.x : 0.f, (s + 1) <= t ? v.y : 0.f);
        }
    }
    __syncthreads();
    {
        const float* c = a.in[1]; const float* aw = a.in[2]; const float* ab = a.in[3]; float* ada = (float*)(ws + WS_ADA);
        for (int it = bid; it < NLAYER * (NADA / 64); it += G) {
            const int l = it / (NADA / 64), e0 = (it % (NADA / 64)) * 64;
            for (int idx = lane; idx < 4096; idx += 64) { const int dd = idx >> 5, b = idx & 31; const float cv = c[b * DM + 128 * wid + dd]; scr[idx] = cv / (1.0f + __expf(-cv)); }
            asm volatile("s_waitcnt lgkmcnt(0)" ::: "memory");
            float acc[32];
#pragma unroll
            for (int b = 0; b < 32; ++b) acc[b] = 0.f;
            const float* wp = aw + ((size_t)l * DM + 128 * wid) * NADA + e0 + lane;
            for (int d0 = 0; d0 < 128; d0 += 16) {
                float wv[16];
#pragma unroll
                for (int j = 0; j < 16; ++j) wv[j] = wp[(size_t)(d0 + j) * NADA];
#pragma unroll
                for (int j = 0; j < 16; ++j) {
#pragma unroll
                    for (int q = 0; q < 8; ++q) { const f32x4 cv = *(const LAS f32x4*)(scr + (d0 + j) * 32 + 4 * q);
                        acc[4 * q + 0] += wv[j] * cv[0]; acc[4 * q + 1] += wv[j] * cv[1]; acc[4 * q + 2] += wv[j] * cv[2]; acc[4 * q + 3] += wv[j] * cv[3]; }
                }
            }
            __syncthreads();
            LAS float* red = (LAS float*)lds;
#pragma unroll
            for (int b = 0; b < 32; ++b) red[(wid * 32 + b) * 64 + lane] = acc[b];
            __syncthreads();
            for (int o = tid; o < 2048; o += NTHREADS) { const int b = o >> 6, e = o & 63; float s = ab[l * NADA + e0 + e];
#pragma unroll
                for (int w = 0; w < 8; ++w) s += red[(w * 32 + b) * 64 + e];
                ada[(size_t)(l * NBATCH + b) * NADA + e0 + e] = s; }
            __syncthreads();
        }
    }
}

__device__ __forceinline__ void norm0_phase(const float* x, bf16_t* xn, float* ssq, const float* gn, const float* sc, int gw, int NGW, int lane) {
    asm volatile("" : "+v"(lane));
    for (int rg = gw; rg < NTOK / 32; rg += NGW) {
        const int b = rg >> 6;
        f32x4 gm[4];
#pragma unroll
        for (int j = 0; j < 4; ++j) { const f32x4 g = *(const f32x4*)(gn + 256 * j + 4 * lane); const f32x4 s = *(const f32x4*)(sc + (size_t)b * NADA + 256 * j + 4 * lane); gm[j] = g * (s + 1.0f); }
        const float* xr = x + (size_t)rg * 32 * DM + 4 * lane;
        bf16_t* orow = xn + (size_t)rg * 32 * DM + 4 * lane;
        f32x4 v[4], nv[4];
#pragma unroll
        for (int j = 0; j < 4; ++j) nv[j] = *(const f32x4*)(xr + 256 * j);
        for (int r = 0; r < 32; ++r) {
#pragma unroll
            for (int j = 0; j < 4; ++j) v[j] = nv[j];
            if (r + 1 < 32) {
#pragma unroll
                for (int j = 0; j < 4; ++j) nv[j] = *(const f32x4*)(xr + (size_t)(r + 1) * DM + 256 * j);
            }
            float ss = 0.f;
#pragma unroll
            for (int j = 0; j < 4; ++j) ss += (v[j][0] * v[j][0] + v[j][1] * v[j][1]) + (v[j][2] * v[j][2] + v[j][3] * v[j][3]);
            ss = wave_sum(ss);
            if (lane == 0) ssq[rg * 32 + r] = ss;
#pragma unroll
            for (int j = 0; j < 4; ++j) { const f32x4 o = v[j] * gm[j]; u32x2 w; w.x = cvt_pk_bf16(o[0], o[1]); w.y = cvt_pk_bf16(o[2], o[3]);
                *(u32x2*)(orow + (size_t)r * DM + 256 * j) = w; }
        }
    }
}
__device__ __forceinline__ void final_norm_phase(float* x, const float* ssq, const float* gn, int gw, int NGW, int lane) {
    asm volatile("" : "+v"(lane));
    f32x4 gm[4];
#pragma unroll
    for (int j = 0; j < 4; ++j) gm[j] = *(const f32x4*)(gn + 256 * j + 4 * lane);
    for (int rg = gw; rg < NTOK / 32; rg += NGW) {
        float* xr = x + (size_t)rg * 32 * DM + 4 * lane;
#pragma unroll 4
        for (int r = 0; r < 32; ++r) {
            const float rstd = __builtin_amdgcn_rsqf(ssq[rg * 32 + r] * (1.0f / DM) + EPS);
#pragma unroll
            for (int j = 0; j < 4; ++j) { float* p = xr + (size_t)r * DM + 256 * j; *(f32x4*)p = *(const f32x4*)p * rstd * gm[j]; }
        }
    }
}

__device__ __forceinline__ void mixer_phase(LAS unsigned char* lds, const bf16_t* PROJ, bf16_t* Y, const bf16_t* Wsb, const float* sgub, const float* lng, const float* lnb,
                                            const float* convw, const float* og, int G, int bid, int wid, int lane) {
    asm volatile("" : "+v"(lane));
    const int fr = lane & 15, fq = lane >> 4, ch8 = lane & 7, rgrp = lane >> 3;
    LAS unsigned char* vT = lds + wid * 16384;
    LAS float* ssq = (LAS float*)(lds + STAGE_BYTES);
    float lg[8], lb[8], ogA[16], w0[8], w1[8], w2[8], ogB[8];
#pragma unroll
    for (int i = 0; i < 8; ++i) { lg[i] = lng[8 * ch8 + i]; lb[i] = lnb[8 * ch8 + i]; w0[i] = convw[8 * lane + i]; w1[i] = convw[512 + 8 * lane + i]; w2[i] = convw[1024 + 8 * lane + i]; ogB[i] = og[512 + 8 * lane + i]; }
#pragma unroll
    for (int i = 0; i < 16; ++i) ogA[i] = og[64 * wid + 16 * fq + i];
    int par = 0;
    for (int ch = bid; ch < NTOK / 128; ch += G, par ^= 1) {
        const size_t r0 = (size_t)ch * 128;
        {
            const size_t r = r0 + 16 * wid;
            const bf16_t* pb = PROJ + r * NPJ + 1024 + 8 * lane;
            float zm1[8], zm2[8];
            const bool first = ((r0 & (SEQ - 1)) == 0) && (wid == 0);
            if (!first) {
                const u32x4 z1v = *(const u32x4*)(pb - NPJ + 512), z2v = *(const u32x4*)(pb - 2 * NPJ + 512);
#pragma unroll
                for (int q = 0; q < 4; ++q) { zm1[2 * q] = bf_lo(z1v[q]); zm1[2 * q + 1] = bf_hi(z1v[q]); zm2[2 * q] = bf_lo(z2v[q]); zm2[2 * q + 1] = bf_hi(z2v[q]); }
            } else {
#pragma unroll
                for (int i = 0; i < 8; ++i) { zm1[i] = 0.f; zm2[i] = 0.f; }
            }
#pragma unroll 8
            for (int t = 0; t < 16; ++t) {
                const u32x4 bgv = *(const u32x4*)(pb + (size_t)t * NPJ), zv = *(const u32x4*)(pb + (size_t)t * NPJ + 512);
                float y[8]; float ss = 0.f;
#pragma unroll
                for (int q = 0; q < 4; ++q) {
                    const float z0 = bf_lo(zv[q]), z1 = bf_hi(zv[q]);
                    y[2 * q] = bf_lo(bgv[q]) * (w0[2 * q] * zm2[2 * q] + w1[2 * q] * zm1[2 * q] + w2[2 * q] * z0);
                    y[2 * q + 1] = bf_hi(bgv[q]) * (w0[2 * q + 1] * zm2[2 * q + 1] + w1[2 * q + 1] * zm1[2 * q + 1] + w2[2 * q + 1] * z1);
                    zm2[2 * q] = zm1[2 * q]; zm1[2 * q] = z0; zm2[2 * q + 1] = zm1[2 * q + 1]; zm1[2 * q + 1] = z1;
                    ss += y[2 * q] * y[2 * q] + y[2 * q + 1] * y[2 * q + 1];
                }
                const float rstd = __builtin_amdgcn_rsqf(wave_sum(ss) * (1.0f / 512.0f) + EPS);
                u32x4 o;
#pragma unroll
                for (int q = 0; q < 4; ++q) o[q] = cvt_pk_bf16(y[2 * q] * rstd * ogB[2 * q], y[2 * q + 1] * rstd * ogB[2 * q + 1]);
                *(u32x4*)(Y + (r + t) * DM + 512 + 8 * lane) = o;
            }
        }
        {
            const bf16_t* pv = PROJ + r0 * NPJ + 512 + 64 * wid + 8 * ch8;
#pragma unroll 8
            for (int it = 0; it < 16; ++it) {
                const int s = 8 * it + rgrp;
                const u32x4 vv = *(const u32x4*)(pv + (size_t)s * NPJ);
                float x[8]; float sm = 0.f;
#pragma unroll
                for (int q = 0; q < 4; ++q) { x[2 * q] = bf_lo(vv[q]); x[2 * q + 1] = bf_hi(vv[q]); sm += x[2 * q] + x[2 * q + 1]; }
                sm = sum_lanes8(sm);
                const float mu = sm * (1.0f / 64.0f); float sq = 0.f;
#pragma unroll
                for (int i = 0; i < 8; ++i) { x[i] -= mu; sq += x[i] * x[i]; }
                sq = sum_lanes8(sq);
                const float rs = __builtin_amdgcn_rsqf(sq * (1.0f / 64.0f) + EPS);
#pragma unroll
                for (int i = 0; i < 8; i += 2) {
                    const unsigned pk = cvt_pk_bf16(x[i] * rs * lg[i] + lb[i], x[i + 1] * rs * lg[i + 1] + lb[i + 1]);
                    const int qq = ch8 >> 1, dt = ((ch8 & 1) << 1) | (i >> 2), j = i & 3, lo15 = 4 * qq + j, rho = 16 * dt + lo15;
                    const int sw0 = (rho & 15) ^ (((rho >> 3) & 1) | (((rho >> 5) & 1) << 1)), sw1 = ((rho + 1) & 15) ^ ((((rho + 1) >> 3) & 1) | ((((rho + 1) >> 5) & 1) << 1));
                    *(LAS unsigned short*)(vT + rho * 256 + ((((s >> 3) ^ sw0) & 15) << 4) + (s & 7) * 2) = (unsigned short)(pk & 0xffffu);
                    *(LAS unsigned short*)(vT + (rho + 1) * 256 + ((((s >> 3) ^ sw1) & 15) << 4) + (s & 7) * 2) = (unsigned short)(pk >> 16);
                }
            }
            asm volatile("s_waitcnt lgkmcnt(0)" ::: "memory");
        }
        unsigned ypk[8][4][2];
        {
            const bf16_t* wb = Wsb + (size_t)wid * 128 * 128;
            const bf16_t* pu = PROJ + r0 * NPJ + 64 * wid + 16 * fq;
#pragma unroll
            for (int i = 0; i < 8; ++i) {
                f32x4 acc[4];
#pragma unroll
                for (int dt = 0; dt < 4; ++dt) acc[dt] = (f32x4){0.f, 0.f, 0.f, 0.f};
                const int t = 16 * i + fr;
                const u32x4 ua = *(const u32x4*)(pu + (size_t)t * NPJ), ub = *(const u32x4*)(pu + (size_t)t * NPJ + 8);
                const float bias = sgub[wid * 128 + t];
#pragma unroll
                for (int ks = 0; ks <= i / 2; ++ks) {
                    const bf16x8 wf = *(const bf16x8*)(wb + (size_t)t * 128 + 32 * ks + 8 * fq);
#pragma unroll
                    for (int dt = 0; dt < 4; ++dt) {
                        const bf16x8 vf = *(const LAS bf16x8*)(vT + (16 * dt + fr) * 256 + ((((4 * ks + fq) ^ (fr ^ ((fr >> 3) | ((dt >> 1) << 1)))) & 15) << 4));
                        acc[dt] = __builtin_amdgcn_mfma_f32_16x16x32_bf16(vf, wf, acc[dt], 0, 0, 0);
                    }
                }
                float ss = 0.f;
#pragma unroll
                for (int dt = 0; dt < 4; ++dt) {
                    const unsigned uw0 = (dt < 2) ? ua[2 * (dt & 1)] : ub[2 * (dt & 1)], uw1 = (dt < 2) ? ua[2 * (dt & 1) + 1] : ub[2 * (dt & 1) + 1];
                    const float y0 = bf_lo(uw0) * (acc[dt][0] + bias), y1 = bf_hi(uw0) * (acc[dt][1] + bias), y2 = bf_lo(uw1) * (acc[dt][2] + bias), y3 = bf_hi(uw1) * (acc[dt][3] + bias);
                    ss += (y0 * y0 + y1 * y1) + (y2 * y2 + y3 * y3);
                    ypk[i][dt][0] = cvt_pk_bf16(y0, y1); ypk[i][dt][1] = cvt_pk_bf16(y2, y3);
                }
                ss = sum_rows(ss);
                ssq[(par * 8 + wid) * 128 + t] = ss;
            }
        }
        __syncthreads();
        {
#pragma unroll
            for (int i = 0; i < 8; ++i) {
                const int t = 16 * i + fr; float tot = 0.f;
#pragma unroll
                for (int h = 0; h < 8; ++h) tot += ssq[(par * 8 + h) * 128 + t];
                const float rstd = __builtin_amdgcn_rsqf(tot * (1.0f / 512.0f) + EPS);
                u32x4 o0, o1;
                o0.x = cvt_pk_bf16(bf_lo(ypk[i][0][0]) * rstd * ogA[0], bf_hi(ypk[i][0][0]) * rstd * ogA[1]); o0.y = cvt_pk_bf16(bf_lo(ypk[i][0][1]) * rstd * ogA[2], bf_hi(ypk[i][0][1]) * rstd * ogA[3]);
                o0.z = cvt_pk_bf16(bf_lo(ypk[i][1][0]) * rstd * ogA[4], bf_hi(ypk[i][1][0]) * rstd * ogA[5]); o0.w = cvt_pk_bf16(bf_lo(ypk[i][1][1]) * rstd * ogA[6], bf_hi(ypk[i][1][1]) * rstd * ogA[7]);
                o1.x = cvt_pk_bf16(bf_lo(ypk[i][2][0]) * rstd * ogA[8], bf_hi(ypk[i][2][0]) * rstd * ogA[9]); o1.y = cvt_pk_bf16(bf_lo(ypk[i][2][1]) * rstd * ogA[10], bf_hi(ypk[i][2][1]) * rstd * ogA[11]);
                o1.z = cvt_pk_bf16(bf_lo(ypk[i][3][0]) * rstd * ogA[12], bf_hi(ypk[i][3][0]) * rstd * ogA[13]); o1.w = cvt_pk_bf16(bf_lo(ypk[i][3][1]) * rstd * ogA[14], bf_hi(ypk[i][3][1]) * rstd * ogA[15]);
                bf16_t* yp = Y + (r0 + t) * DM + 64 * wid + 16 * fq;
                *(u32x4*)yp = o0; *(u32x4*)(yp + 8) = o1;
            }
        }
    }
    __syncthreads();
}

template <int L>
__device__ __forceinline__ void layer(LAS unsigned char* lds, const Args& a, const XcdBarrier& bar, int G, int bid, int wid, int lane) {
    unsigned char* ws = a.ws; float* out = a.out;
    bf16_t* XN = (bf16_t*)(ws + WS_XN); bf16_t* HB = (bf16_t*)(ws + WS_HB); bf16_t* YB = (bf16_t*)(ws + WS_YB);
    const float* ada = (const float*)(ws + WS_ADA) + (size_t)L * NBATCH * NADA;
    const unsigned char* wk = ws + WS_WK1 + (size_t)L * WK1_STRIDE; const unsigned char* wo = ws + WS_WOTH + (size_t)L * WOTH_STRIDE;
    bf16_t* XB = (bf16_t*)(ws + WS_XB);
    float* ssq = (float*)(ws + WS_SSQ) + (size_t)(3 * L) * NTOK; const float* gmb = (const float*)(ws + WS_GMB) + (size_t)(3 * L) * NBATCH * DM;
    const float* bias = (const float*)(ws + WS_BIAS) + (size_t)(3 * L) * (MiB / 4);
    { pg8::EpiSwiglu E{HB, ssq, bias}; pg8::gemm_phase<NTOK, NGU, DM>(lds, XN, (const bf16_t*)(wk + WK1_GU1), G, bid, E); }
    xcd_barrier(bar);
    { pg8::EpiResid<L == 0, false> E{(L == 0) ? (const void*)a.in[0] : (const void*)XB, XB, ada + 2 * DM, ssq + NTOK, gmb + NBATCH * DM, XN, 0.5f, 0}; pg8::gemm_phase<NTOK, DM, FF>(lds, HB, (const bf16_t*)(wo + WO_D1), G, bid, E); }
    xcd_barrier(bar);
    { pg8::EpiProj E{HB, ssq + NTOK, bias + MiB / 4}; pg8::gemm_phase<NTOK, NIN, DM>(lds, XN, (const bf16_t*)(wk + WK1_IN), G, bid, E); }
    xcd_barrier(bar);
    mixer_phase(lds, HB, YB, (const bf16_t*)(ws + WS_WSGU) + (size_t)L * 8 * 128 * 128, a.in[12] + L * 8 * 128, a.in[9] + L * 64, a.in[10] + L * 64,
                a.in[13] + L * 3 * 512, a.in[14] + L * DM, G, bid, wid, lane);
    xcd_barrier(bar);
    { pg8::EpiResid<false, false> E{XB, XB, ada + 5 * DM, ssq + 2 * NTOK, gmb + 2 * NBATCH * DM, XN, 1.0f, 0}; pg8::gemm_phase<NTOK, DM, DM>(lds, YB, (const bf16_t*)(wo + WO_OUT), G, bid, E); }
    xcd_barrier(bar);
    { pg8::EpiSwiglu E{HB, ssq + 2 * NTOK, bias + 2 * (MiB / 4)}; pg8::gemm_phase<NTOK, NGU, DM>(lds, XN, (const bf16_t*)(wk + WK1_GU2), G, bid, E); }
    xcd_barrier(bar);
    { pg8::EpiResid<false, (L + 1 == NLAYER)> E{XB, (L + 1 == NLAYER) ? (void*)out : (void*)XB, ada + 8 * DM, ssq + 3 * NTOK, (L + 1 < NLAYER) ? gmb + 3 * NBATCH * DM : nullptr, XN, 0.5f, 0}; pg8::gemm_phase<NTOK, DM, FF>(lds, HB, (const bf16_t*)(wo + WO_D2), G, bid, E); }
    xcd_barrier(bar);
}

__global__ void __launch_bounds__(NTHREADS, 2) fwd_megakernel(Args a) {
    extern __shared__ __attribute__((aligned(16))) unsigned char lds_raw[];
    LAS unsigned char* lds = (LAS unsigned char*)lds_raw;
    cg::grid_group grid = cg::this_grid();
    const int tid = threadIdx.x, lane = tid & 63, wid = __builtin_amdgcn_readfirstlane(tid >> 6);
    const int G = gridDim.x, bid = blockIdx.x;
    const int gw = bid * NWAVES + wid, NGW = G * NWAVES;
    unsigned char* ws = a.ws;

    unsigned* barw = (unsigned*)(ws + WS_BAR);
    if (bid == 0) for (int i = tid; i < XCD_BAR_WORDS; i += NTHREADS) barw[i] = 0u;
    volatile LAS unsigned* bst = (volatile LAS unsigned*)(lds + STAGE_BYTES + 8192);
    if (tid == 0) { bst[0] = 0u; bst[1] = 0u; }
    prologue(lds, a, G, bid, tid, wid, lane);
    grid.sync();
    const XcdBarrier bar = xcd_barrier_post(barw, bst);

    {
        const float* ada0 = (const float*)(ws + WS_ADA); float* GMB = (float*)(ws + WS_GMB);
        for (int i = bid * NTHREADS + tid; i < 6 * NBATCH * DM; i += G * NTHREADS) {
            const int c = i & (DM - 1), b = (i >> 10) & 31, j = i >> 15, l = j / 3, sub = j % 3;
            const float* gsrc = (sub == 0 ? a.in[4] : (sub == 1 ? a.in[7] : a.in[16])) + l * DM;
            const float* ad = ada0 + (size_t)(l * NBATCH + b) * NADA + 3 * sub * DM;
            GMB[i] = gsrc[c] * (1.0f + ad[DM + c]);
            ((bf16_t*)(ws + WS_SHM))[i] = (bf16_t)(cvt_pk_bf16(ad[c], 0.f) & 0xffffu);
        }
        for (int i = bid * NTHREADS + tid; i < 64 * DM / 2; i += G * NTHREADS) ((unsigned*)(ws + WS_SHM))[192 * DM / 2 + i] = 0u;
        norm0_phase(a.in[0], (bf16_t*)(ws + WS_XN), (float*)(ws + WS_SSQ), a.in[4], ada0 + 1 * DM, gw, NGW, lane);
    }
    xcd_barrier(bar);
    { pg8::EpiBias E{(float*)(ws + WS_BIAS)}; pg8::gemm_phase<256, 2 * (2 * NGU + NIN), DM>(lds, (const bf16_t*)(ws + WS_SHM), (const bf16_t*)(ws + WS_WK1), G, bid, E); }
    xcd_barrier(bar);
    layer<0>(lds, a, bar, G, bid, wid, lane);
    layer<1>(lds, a, bar, G, bid, wid, lane);
    final_norm_phase(a.out, (const float*)(ws + WS_SSQ) + (size_t)6 * NTOK, a.in[19], gw, NGW, lane);
}

extern "C" void kernel_launch(void* const* d_in, const int* in_sizes, int n_in, void* d_out, int out_size, void* d_ws, size_t ws_size, hipStream_t stream) {
    static int grid = 0;
    if (grid == 0) {
        if (n_in != 20 || in_sizes[0] != NTOK * DM || out_size != NTOK * DM || ws_size < WS_END) {
            fprintf(stderr, "kernel_launch: unexpected shapes (n_in %d, in0 %d, out %d, ws %zu)\n", n_in, n_in > 0 ? in_sizes[0] : -1, out_size, ws_size); grid = -1; return; }
        int dev = 0, cus = 0, per_cu = 0;
        hipGetDevice(&dev);
        hipDeviceGetAttribute(&cus, hipDeviceAttributeMultiprocessorCount, dev);
        if (hipFuncSetAttribute((const void*)fwd_megakernel, hipFuncAttributeMaxDynamicSharedMemorySize, LDS_BYTES) != hipSuccess) { fprintf(stderr, "kernel_launch: hipFuncSetAttribute failed\n"); grid = -1; return; }
        if (hipOccupancyMaxActiveBlocksPerMultiprocessor(&per_cu, (const void*)fwd_megakernel, NTHREADS, LDS_BYTES) != hipSuccess || per_cu < 1) { fprintf(stderr, "kernel_launch: occupancy query says %d\n", per_cu); per_cu = 1; }
        (void)hipGetLastError();
        grid = cus;
    }
    if (grid < 0) return;
    Args a{};
    for (int i = 0; i < 20; ++i) a.in[i] = (const float*)d_in[i];
    a.out = (float*)d_out; a.ws = (unsigned char*)d_ws;
    void* args[] = {&a};
    hipError_t e = hipLaunchCooperativeKernel((const void*)fwd_megakernel, dim3(grid), dim3(NTHREADS), args, LDS_BYTES, stream);
    if (e != hipSuccess) fprintf(stderr, "kernel_launch: cooperative launch failed: %s (grid %d)\n", hipGetErrorString(e), grid);
}
```
